# Optimizing an MI355X kernel written in HIP

```python
import jax
import jax.numpy as jnp
from jax import lax
import numpy as np


D_MODEL = 2048
BATCH = 2
SEQ = 16384
DEPTH = 4

GRID_W = 64
CTX_LEN = 256

GLA_HEADS = 4
GLA_DK = 256
GLA_DV = 256
GLA_KEY_W = GLA_HEADS * GLA_DK
GLA_VAL_W = GLA_HEADS * GLA_DV
GLA_GATE_RANK = 16
GLA_TAU = 16.0
GLA_CHUNK = 64

CONV_W = D_MODEL // 2
CONV_K = 3

POOL_W = D_MODEL
POOL_WINDOWS = (2, 4, 8, 16)
POOL_GROUP = POOL_W // len(POOL_WINDOWS)

E_SIZES = (GLA_KEY_W, GLA_VAL_W, GLA_GATE_RANK, GLA_GATE_RANK, GLA_KEY_W, GLA_VAL_W,
           CONV_W, CONV_W, CONV_W, CONV_W)
E_IN = sum(E_SIZES)
E_STATE_COLS = GLA_KEY_W + GLA_VAL_W + 2 * GLA_GATE_RANK
E_MIX = GLA_VAL_W + CONV_W
O_IN = 2 * POOL_W
LN_EPS = 1e-5

kernel_name = 'hybrid_gla_shortconv_pool_deepnorm_prefix'


def layer_norm(x, g, b):
    xf = x.astype(jnp.float32)
    mu = jnp.mean(xf, axis=-1, keepdims=True)
    var = jnp.mean(jnp.square(xf - mu), axis=-1, keepdims=True)
    return ((xf - mu) * lax.rsqrt(var + LN_EPS)).astype(x.dtype) * g + b


def rms_norm(x, g):
    xf = x.astype(jnp.float32)
    return xf * lax.rsqrt(jnp.mean(jnp.square(xf), axis=-1, keepdims=True) + LN_EPS) * g.astype(jnp.float32)


def modulation(cond, w, b, n):
    m = jax.nn.silu(cond) @ w[:, :n * D_MODEL] + b[:n * D_MODEL]
    return jnp.split(m, n, axis=-1)


def split_cols(h, sizes):
    idx = [int(i) for i in np.cumsum(sizes)[:-1]]
    return jnp.split(h, idx, axis=-1)


def to_heads(t, d):
    bn, L, _ = t.shape
    return t.reshape(bn, L, -1, d).transpose(0, 2, 1, 3)


def from_heads(t):
    bn, H, L, d = t.shape
    return t.transpose(0, 2, 1, 3).reshape(bn, L, H * d)


def flip_seq(t):
    return jnp.flip(t, axis=2)


def gate_log(r, w, b):
    return jax.nn.log_sigmoid((r @ w + b).astype(jnp.float32)) / GLA_TAU


def gla_chunked(q, k, v, log_a, s0):
    bn, H, L, _ = q.shape
    dv = v.shape[-1]
    C = GLA_CHUNK
    nc = L // C

    def to_chunks(t):
        return jnp.moveaxis(t.astype(jnp.float32).reshape(bn, H, nc, C, t.shape[-1]), 2, 0)

    lower = np.tril(np.ones((C, C), dtype=bool))[:, :, None]

    def step(s, inp):
        qc, kc, vc, lac = inp
        g = jnp.cumsum(lac, axis=-2)
        diff = g[..., :, None, :] - g[..., None, :, :]
        decay = jnp.exp(jnp.where(lower, diff, -jnp.inf))
        scores = jnp.einsum('bhik,bhjk,bhijk->bhij', qc, kc, decay)
        o = (jnp.einsum('bhij,bhjv->bhiv', scores, vc)
             + jnp.einsum('bhik,bhkv->bhiv', qc * jnp.exp(g), s))
        g_last = g[..., -1:, :]
        s_new = (jnp.exp(g_last)[..., 0, :, None] * s
                 + jnp.einsum('bhjk,bhjv->bhkv', kc * jnp.exp(g_last - g), vc))
        return s_new, o

    s_fin, o = lax.scan(step, s0, (to_chunks(q), to_chunks(k), to_chunks(v), to_chunks(log_a)))
    o = jnp.moveaxis(o, 0, 2).reshape(bn, H, L, dv)
    return o, s_fin


def gla_final_state(k, v, log_a):
    g = jnp.cumsum(log_a, axis=-2)
    return jnp.einsum('bhtk,bhtv->bhkv', k * jnp.exp(g[..., -1:, :] - g), v)


def context_states(hs, w_gf, b_gf, w_gb, b_gb):
    k, v, rf, rb = split_cols(hs, E_SIZES[:4])
    k = to_heads(k, GLA_DK).astype(jnp.float32)
    v = to_heads(v, GLA_DV).astype(jnp.float32)
    la_f = to_heads(gate_log(rf, w_gf, b_gf), GLA_DK)
    la_b = to_heads(gate_log(rb, w_gb, b_gb), GLA_DK)
    s_f = gla_final_state(k, v, la_f)
    s_b = gla_final_state(flip_seq(k), flip_seq(v), flip_seq(la_b))
    return s_f, s_b


def conv3_centred(x, w):
    zero = jnp.zeros_like(x[..., :1, :])
    x_prev = jnp.concatenate([zero, x[..., :-1, :]], axis=-2)
    x_next = jnp.concatenate([x[..., 1:, :], zero], axis=-2)
    return w[0] * x_prev + w[1] * x + w[2] * x_next


def centred_window_mean(x, window, axis):
    L = x.shape[axis]
    xf = jnp.moveaxis(x, axis, 0).astype(jnp.float32)
    cs = jnp.concatenate([jnp.zeros_like(xf[:1]), jnp.cumsum(xf, axis=0)], axis=0)
    t = np.arange(L)
    lo = np.clip(t - window // 2, 0, L)
    hi = np.clip(t + window - window // 2, 0, L)
    cnt = (hi - lo).astype(np.float32).reshape((L,) + (1,) * (xf.ndim - 1))
    mean = (cs[hi] - cs[lo]) / cnt
    return jnp.moveaxis(mean, 0, axis).astype(x.dtype)


def even_mixer(h, s0_f, s0_b, w_gf, b_gf, w_gb, b_gb, gla_norm_w, conv_w, w_out, grid):
    bn, L, _ = h.shape
    k, v, rf, rb, q, gate_b, a_b, a_c, a_x, gate_a = split_cols(h, E_SIZES)
    qh = to_heads(q * (GLA_DK ** -0.5), GLA_DK)
    kh = to_heads(k, GLA_DK)
    vh = to_heads(v, GLA_DV)
    la_f = to_heads(gate_log(rf, w_gf, b_gf), GLA_DK)
    la_b = to_heads(gate_log(rb, w_gb, b_gb), GLA_DK)
    o_f, s_f = gla_chunked(qh, kh, vh, la_f, s0_f)
    o_b, s_b = gla_chunked(flip_seq(qh), flip_seq(kh), flip_seq(vh), flip_seq(la_b), s0_b)
    o = rms_norm(o_f + flip_seq(o_b), gla_norm_w)
    y_b = from_heads(o).astype(h.dtype) * jax.nn.silu(gate_b)
    u = (a_c * a_x).reshape(bn, grid[0], grid[1], CONV_W)
    u = conv3_centred(u, conv_w).reshape(bn, L, CONV_W)
    y_a = a_b * u * jax.nn.silu(gate_a)
    return jnp.concatenate([y_b, y_a], axis=-1) @ w_out, s_f, s_b


def odd_mixer(h, w_pool, pool_scale, w_out, grid):
    bn, L, _ = h.shape
    xp, gate = jnp.split(h, 2, axis=-1)
    xg = xp.reshape(bn, grid[0], grid[1], POOL_W)
    groups = jnp.split(xg, len(POOL_WINDOWS), axis=-1)
    z = jnp.stack([centred_window_mean(g, w, 1) - g for g, w in zip(groups, POOL_WINDOWS)], axis=-2)
    z = jnp.einsum('brcgi,gio->brcgo', z, w_pool).reshape(bn, L, POOL_W) * pool_scale
    return (z * jax.nn.silu(gate)) @ w_out


def setup_inputs(seed: int = 0) -> dict:
    key = jax.random.key(seed)
    ks = jax.random.split(key, 20)
    ne = (DEPTH + 1) // 2
    no = DEPTH // 2
    beta = (8.0 * DEPTH) ** -0.25

    def nrm(k, shape, s):
        return jax.random.normal(k, shape, jnp.float32) * s

    return {
        'x': nrm(ks[0], (BATCH, SEQ, D_MODEL), 1.0),
        'c': nrm(ks[1], (BATCH, D_MODEL), 1.0),
        'ctx': nrm(ks[2], (BATCH, CTX_LEN, D_MODEL), 1.0),
        'c_ctx': nrm(ks[3], (D_MODEL,), 1.0),
        'w_ada': nrm(ks[4], (DEPTH, D_MODEL, 3 * D_MODEL), 0.5 * D_MODEL ** -0.5),
        'b_ada': nrm(ks[5], (DEPTH, 3 * D_MODEL), 0.02),
        'ln_g': 1.0 + nrm(ks[6], (DEPTH, D_MODEL), 0.02),
        'ln_b': nrm(ks[7], (DEPTH, D_MODEL), 0.02),
        'w_in_e': nrm(ks[8], (ne, D_MODEL, E_IN), D_MODEL ** -0.5),
        'w_gate_f': nrm(ks[9], (ne, GLA_GATE_RANK, GLA_KEY_W), GLA_GATE_RANK ** -0.5),
        'b_gate_f': nrm(ks[10], (ne, GLA_KEY_W), 0.1),
        'w_gate_b': nrm(ks[11], (ne, GLA_GATE_RANK, GLA_KEY_W), GLA_GATE_RANK ** -0.5),
        'b_gate_b': nrm(ks[12], (ne, GLA_KEY_W), 0.1),
        'gla_norm_w': 1.0 + nrm(ks[13], (ne, GLA_DV), 0.02),
        'conv_w': nrm(ks[14], (ne, CONV_K, CONV_W), CONV_K ** -0.5),
        'w_out_e': nrm(ks[15], (ne, E_MIX, D_MODEL), beta * E_MIX ** -0.5),
        'w_in_o': nrm(ks[16], (no, D_MODEL, O_IN), D_MODEL ** -0.5),
        'w_pool': nrm(ks[17], (no, len(POOL_WINDOWS), POOL_GROUP, POOL_GROUP), POOL_GROUP ** -0.5),
        'pool_scale': 1.0 + nrm(ks[18], (no, POOL_W), 0.02),
        'w_out_o': nrm(ks[19], (no, POOL_W, D_MODEL), beta * POOL_W ** -0.5),
    }


def reference(x, c, ctx, c_ctx, w_ada, b_ada, ln_g, ln_b, w_in_e, w_gate_f, b_gate_f,
              w_gate_b, b_gate_b, gla_norm_w, conv_w, w_out_e, w_in_o, w_pool, pool_scale, w_out_o):
    alpha = (2.0 * DEPTH) ** 0.25
    bn, L, _ = x.shape
    rows = L // GRID_W
    lc = ctx.shape[1]
    c_lat = c[:, None, :]
    c_c = c_ctx[None, None, :]
    s_zero = jnp.zeros((bn, GLA_HEADS, GLA_DK, GLA_DV), jnp.float32)
    ctx_s = ctx
    for i in range(DEPTH):
        j = i // 2
        ctx_needed = any(l % 2 == 0 for l in range(i + 1, DEPTH))
        sh, sc, gt = modulation(c_lat, w_ada[i], b_ada[i], 3)
        u = x * (1.0 + sc) + sh
        if i % 2 == 0:
            if ctx_needed:
                sh_c, sc_c, gt_c = modulation(c_c, w_ada[i], b_ada[i], 3)
                uc = ctx_s * (1.0 + sc_c) + sh_c
                yc, s_f, s_b = even_mixer(uc @ w_in_e[j], s_zero, s_zero, w_gate_f[j], b_gate_f[j],
                                          w_gate_b[j], b_gate_b[j], gla_norm_w[j], conv_w[j],
                                          w_out_e[j], (1, lc))
                ctx_s = layer_norm(alpha * ctx_s + gt_c * yc, ln_g[i], ln_b[i])
            else:
                sh_c, sc_c = modulation(c_c, w_ada[i], b_ada[i], 2)
                uc = ctx_s * (1.0 + sc_c) + sh_c
                s_f, s_b = context_states(uc @ w_in_e[j][:, :E_STATE_COLS], w_gate_f[j], b_gate_f[j],
                                          w_gate_b[j], b_gate_b[j])
            y, _, _ = even_mixer(u @ w_in_e[j], s_f, s_b, w_gate_f[j], b_gate_f[j], w_gate_b[j],
                                 b_gate_b[j], gla_norm_w[j], conv_w[j], w_out_e[j], (rows, GRID_W))
        else:
            if ctx_needed:
                sh_c, sc_c, gt_c = modulation(c_c, w_ada[i], b_ada[i], 3)
                uc = ctx_s * (1.0 + sc_c) + sh_c
                yc = odd_mixer(uc @ w_in_o[j], w_pool[j], pool_scale[j], w_out_o[j], (lc, 1))
                ctx_s = layer_norm(alpha * ctx_s + gt_c * yc, ln_g[i], ln_b[i])
            y = odd_mixer(u @ w_in_o[j], w_pool[j], pool_scale[j], w_out_o[j], (rows, GRID_W))
        x = layer_norm(alpha * x + gt * y, ln_g[i], ln_b[i])
    return x
```

```cpp
#include <hip/hip_runtime.h>
#include <hip/hip_cooperative_groups.h>
#include <cstdio>
namespace cg = cooperative_groups;

#ifndef MULTI
#define MULTI 0
#endif
#define DUP -1

#define DI __device__ __forceinline__
#define LAS __attribute__((address_space(3)))
typedef unsigned short bf16_t;
typedef short bf16x8 __attribute__((ext_vector_type(8)));
typedef float f32x2 __attribute__((ext_vector_type(2)));
typedef float f32x4 __attribute__((ext_vector_type(4)));
typedef float f32x16 __attribute__((ext_vector_type(16)));
typedef unsigned u32x2 __attribute__((ext_vector_type(2)));
typedef unsigned u32x4 __attribute__((ext_vector_type(4)));
typedef __bf16 bfv2 __attribute__((ext_vector_type(2)));

constexpr int D = 2048, TL = 32768, TC = 512, R = TL + TC, NCH = R / 64;
constexpr int HE = 8448, HO = 4096;
constexpr float ALPHA = 1.6817928305074290f;
constexpr float LN_EPS = 1e-5f;
constexpr size_t MB = 1u << 20;
constexpr size_t WS_MOD = 0, WS_STATS = 1 * MB, WS_CTXV = 2 * MB, WS_WIN = 6 * MB, WS_WPOOL = 40 * MB, WS_WOUT = 42 * MB,
                 WS_U = 50 * MB, WS_H = 180 * MB, WS_KH = 717 * MB, WS_AM = 847 * MB, WS_DD = 880 * MB, WS_VT = 885 * MB, WS_BAR = 950 * MB, WS_WINB = 952 * MB, WS_WOUT_B = 960 * MB, WS_WIN_B = 968 * MB, WS_WOUT_C = 1002 * MB, WS_END = 1010 * MB;
constexpr int LDS_MAIN = 143360, LDS_BYTES = LDS_MAIN + 16;
constexpr int NPHASE = 24;

struct Params {
    const float* in[20];
    float* out;
    unsigned char* ws;
    int ph_lo, ph_hi;
};

DI float bf2f(bf16_t b) { return __uint_as_float(((unsigned)b) << 16); }
DI unsigned pk2(float lo, float hi) { f32x2 v = {lo, hi}; bfv2 b = __builtin_convertvector(v, bfv2); return __builtin_bit_cast(unsigned, b); }
DI bf16_t f2bf(float f) { return (bf16_t)(pk2(f, 0.f) & 0xffffu); }
DI float lo_bf(unsigned u) { return __uint_as_float(u << 16); }
DI float hi_bf(unsigned u) { return __uint_as_float(u & 0xffff0000u); }
DI float silu(float x) { return x / (1.f + __expf(-x)); }
DI float wave_sum(float v) {
#pragma unroll
    for (int o = 32; o > 0; o >>= 1) v += __shfl_xor(v, o);
    return v;
}
DI unsigned xb_ld(unsigned* p)              { return __hip_atomic_load(p, __ATOMIC_RELAXED, __HIP_MEMORY_SCOPE_AGENT); }
DI unsigned xb_add(unsigned* p, unsigned v) { return __hip_atomic_fetch_add(p, v, __ATOMIC_RELAXED, __HIP_MEMORY_SCOPE_AGENT); }
DI size_t win_off(int layer) { return layer == 2 ? WS_WIN_B : WS_WIN; }
DI size_t wout_off(int layer) { return layer == 0 ? WS_WOUT : (layer == 2 ? WS_WOUT_C : WS_WOUT_B); }
DI void mini_barrier(unsigned* cnt, unsigned expected) {
    asm volatile("s_waitcnt vmcnt(0)" ::: "memory");
    __syncthreads();
    if (threadIdx.x == 0) {
        __builtin_amdgcn_fence(__ATOMIC_RELEASE, "agent");
        asm volatile("s_waitcnt vmcnt(0)" ::: "memory");
        (void)xb_add(cnt, 1u);
        unsigned sp = 0; while (xb_ld(cnt) < expected) { __builtin_amdgcn_s_sleep(1); if (++sp > (1u << 22)) break; }
        __builtin_amdgcn_fence(__ATOMIC_ACQUIRE, "agent");
        asm volatile("s_waitcnt vmcnt(0)" ::: "memory");
    }
    __syncthreads();
}
DI int cond_of_row(int r) { return r < 16384 ? 0 : (r < 32768 ? 1 : 2); }
DI float* vrow(const Params& p, int r) { return r < TL ? p.out + (size_t)r * D : (float*)(p.ws + WS_CTXV) + (size_t)(r - TL) * D; }
DI const float* xin_row(const Params& p, int r) { return r < TL ? p.in[0] + (size_t)r * D : p.in[2] + (size_t)(r - TL) * D; }

namespace pg8 {
constexpr int BM = 256, BK = 64, HALF = 128, HTB = HALF * BK * 2, STAGE_BYTES = 8 * HTB, NXCD = 8, WGM = 8;
DI int lds_byte(int r, int c) { const int st = (r >> 4) * 2 + (c >> 5), rr = r & 15, cc = c & 31, ob = rr * 64 + cc * 2; return st * 1024 + (ob ^ (((ob >> 9) & 1) << 5)); }
DI void stage_rc(int b, int& Rr, int& C) { const int st = b / 1024, sb = b % 1024, swz = sb ^ (((sb >> 9) & 1) << 5); Rr = (st >> 1) * 16 + swz / 64; C = (st & 1) * 32 + (swz % 64) / 2; }
DI int perm32(int rho) { const int n = rho >> 4, i = rho & 15; return 8 * (i >> 2) + 4 * n + (i & 3); }
struct Unit { int pm, pn; };
struct Gemm { const bf16_t* A; const bf16_t* Bt; int M, N, K, lda, agroup, ldb, bgroup; };
struct StaticOrder {
    int nM, nN, nwg, G, c;
    DI void init(int M, int N, int G_, int c_) { nM = M / BM; nN = N / BM; nwg = nM * nN; G = G_; c = c_; }
    DI bool next(int i, Unit& u) const {
        const long L = (long)i * G + c; if (L >= nwg) return false;
        int wgid = (int)L; { const int q = nwg / NXCD, r = nwg % NXCD, xcd = wgid % NXCD, off = wgid / NXCD; wgid = (xcd < r ? xcd * (q + 1) : r * (q + 1) + (xcd - r) * q) + off; }
        const int nig = WGM * nN, gid = wgid / nig, fm = gid * WGM, gsz = (nM - fm) < WGM ? (nM - fm) : WGM;
        u.pm = fm + ((wgid % nig) % gsz); u.pn = (wgid % nig) / gsz; return true;
    }
};

template <class Epi>
DI void gemm_phase(LAS unsigned char* lds, const Gemm g, const StaticOrder& S, const Epi& E) {
    const int tid = threadIdx.x, wid = __builtin_amdgcn_readfirstlane(tid >> 6), lane = tid & 63, wr = wid >> 2, wc = wid & 3, fr = lane & 15, fq = lane >> 4;
    const int K = g.K, nt = K / BK, lda = g.lda, ldb = g.ldb;
    unsigned voffA[2], voffB[2];
#pragma unroll
    for (int i = 0; i < 2; ++i) { int Rr, C; stage_rc(tid * 16 + i * 8192, Rr, C); const int Rb = Epi::PERM ? ((Rr & ~31) + perm32(Rr & 31)) : Rr;
        voffA[i] = (unsigned)(Rr * lda + C) * 2u; voffB[i] = (unsigned)(Rb * ldb + C) * 2u; }
    const size_t kstep = (size_t)(BK * 2);
    const size_t hstepA = (size_t)HALF * lda * 2, hstepB = (size_t)HALF * ldb * 2;
    const size_t tstepA = 2 * hstepA, tstepB = 2 * hstepB;
    const unsigned ldsw = (unsigned)wid * 1024u;
    const int aoff = lds_byte(wr * 64 + fr, fq * 8), boff = lds_byte(wc * 32 + fr, fq * 8);
#define PG8_SA(b, h) (((b) * 2 + (h)) * HTB)
#define PG8_SB(b, h) ((4 + (b) * 2 + (h)) * HTB)
#define PG8_STAGE(bufoff, gbase, voff) do { _Pragma("unroll") for (int _i = 0; _i < 2; ++_i) \
        __builtin_amdgcn_global_load_lds((const unsigned*)((const char*)(gbase) + (voff)[_i]), (LAS unsigned*)(lds + (bufoff) + ldsw + _i * 8192), 16, 0, 0); } while (0)
#define PG8_LDA(dst, b, h) do { _Pragma("unroll") for (int m = 0; m < 4; ++m) _Pragma("unroll") for (int k = 0; k < 2; ++k) dst[m][k] = *(const LAS bf16x8*)(lds + PG8_SA(b, h) + aoff + m * 2048 + k * 1024); } while (0)
#define PG8_LDB(dst, b, h) do { _Pragma("unroll") for (int n = 0; n < 2; ++n) _Pragma("unroll") for (int k = 0; k < 2; ++k) dst[n][k] = *(const LAS bf16x8*)(lds + PG8_SB(b, h) + boff + n * 2048 + k * 1024); } while (0)
#define PG8_MMA(ai, bj, At, Bt) do { __builtin_amdgcn_s_setprio(1); _Pragma("unroll") for (int m = 0; m < 4; ++m) _Pragma("unroll") for (int n = 0; n < 2; ++n) _Pragma("unroll") for (int k = 0; k < 2; ++k) \
        acc[ai][bj][m][n] = __builtin_amdgcn_mfma_f32_16x16x32_bf16(Bt[n][k], At[m][k], acc[ai][bj][m][n], 0, 0, 0); __builtin_amdgcn_s_setprio(0); } while (0)
#define PG8_WAIT_V(n) asm volatile("s_waitcnt vmcnt(" #n ")" ::: "memory")
#define PG8_WAIT_L(n) asm volatile("s_waitcnt lgkmcnt(" #n ")" ::: "memory")
#define PG8_BAR __builtin_amdgcn_s_barrier()
#define PG8_SCHED __builtin_amdgcn_sched_barrier(0)
#define PG8_ABASE(u) ((const char*)g.A + (size_t)(u).pm * tstepA + (g.agroup ? (size_t)((u).pn >> 1) * 1024 : (size_t)0))
#define PG8_BBASE(u) ((const char*)g.Bt + (size_t)(u).pn * tstepB + (g.bgroup ? (size_t)((u).pm >> 1) * 1024 : (size_t)0))
    Unit cur, nxt; int ui = 0;
    if (!S.next(0, cur)) return;
    f32x4 acc[2][2][4][2];
#pragma unroll
    for (int a = 0; a < 2; ++a)
#pragma unroll
        for (int b = 0; b < 2; ++b)
#pragma unroll
            for (int m = 0; m < 4; ++m)
#pragma unroll
                for (int n = 0; n < 2; ++n) acc[a][b][m][n] = (f32x4){0.f, 0.f, 0.f, 0.f};
    bf16x8 At[4][2], B0[2][2], B1[2][2];
    const char* cA = PG8_ABASE(cur); const char* cB = PG8_BBASE(cur);
    PG8_STAGE(PG8_SB(0, 0), cB, voffB); PG8_STAGE(PG8_SA(0, 0), cA, voffA); PG8_STAGE(PG8_SB(0, 1), cB + hstepB, voffB); PG8_STAGE(PG8_SA(0, 1), cA + hstepA, voffA);
    if (wr == 1) PG8_BAR;
    PG8_WAIT_V(4); PG8_BAR;
    PG8_STAGE(PG8_SB(1, 0), cB + kstep, voffB); PG8_STAGE(PG8_SA(1, 0), cA + kstep, voffA); PG8_STAGE(PG8_SB(1, 1), cB + hstepB + kstep, voffB);
    PG8_WAIT_V(6); PG8_BAR;
    for (;;) {
        const bool has_next = S.next(ui + 1, nxt);
        const char* nA = has_next ? PG8_ABASE(nxt) : cA; const char* nB = has_next ? PG8_BBASE(nxt) : cB;
        for (int t = 0; t < nt; t += 2) {
            const bool last = (t == nt - 2);
            const char* a1 = cA + (size_t)(t + 1) * kstep;
            const char* a2 = last ? nA : cA + (size_t)(t + 2) * kstep; const char* b2 = last ? nB : cB + (size_t)(t + 2) * kstep;
            const char* a3 = a2 + kstep; const char* b3 = b2 + kstep;
            PG8_LDB(B0, 0, 0); PG8_SCHED; PG8_LDA(At, 0, 0); PG8_STAGE(PG8_SA(1, 1), a1 + hstepA, voffA);
            PG8_WAIT_L(8); PG8_BAR; PG8_WAIT_L(0); PG8_MMA(0, 0, At, B0); PG8_BAR; PG8_SCHED;
            PG8_LDB(B1, 0, 1); PG8_STAGE(PG8_SB(0, 0), b2, voffB);
            PG8_BAR; PG8_WAIT_L(0); PG8_MMA(0, 1, At, B1); PG8_BAR;
            PG8_LDA(At, 0, 1); PG8_STAGE(PG8_SA(0, 0), a2, voffA);
            PG8_BAR; PG8_WAIT_L(0); PG8_MMA(1, 0, At, B0); PG8_BAR; PG8_SCHED;
            PG8_STAGE(PG8_SB(0, 1), b2 + hstepB, voffB);
            PG8_WAIT_V(6); PG8_BAR; PG8_MMA(1, 1, At, B1); PG8_BAR;
            PG8_LDB(B0, 1, 0); PG8_SCHED; PG8_LDA(At, 1, 0); PG8_STAGE(PG8_SA(0, 1), a2 + hstepA, voffA);
            PG8_WAIT_L(8); PG8_BAR; PG8_WAIT_L(0); PG8_MMA(0, 0, At, B0); PG8_BAR; PG8_SCHED;
            PG8_LDB(B1, 1, 1); PG8_STAGE(PG8_SB(1, 0), b3, voffB);
            PG8_BAR; PG8_WAIT_L(0); PG8_MMA(0, 1, At, B1); PG8_BAR;
            PG8_LDA(At, 1, 1); PG8_STAGE(PG8_SA(1, 0), a3, voffA);
            PG8_BAR; PG8_WAIT_L(0); PG8_MMA(1, 0, At, B0); PG8_BAR; PG8_SCHED;
            PG8_STAGE(PG8_SB(1, 1), b3 + hstepB, voffB);
            PG8_WAIT_V(6); PG8_BAR; PG8_MMA(1, 1, At, B1); PG8_BAR;
        }
        E(acc, cur, wr, wc, fr, fq);
        if (!has_next) break;
#pragma unroll
        for (int a = 0; a < 2; ++a)
#pragma unroll
            for (int b = 0; b < 2; ++b)
#pragma unroll
                for (int m = 0; m < 4; ++m)
#pragma unroll
                    for (int n = 0; n < 2; ++n) acc[a][b][m][n] = (f32x4){0.f, 0.f, 0.f, 0.f};
        cur = nxt; cA = nA; cB = nB; ++ui;
    }
    PG8_WAIT_V(0);
    if (wr == 0) PG8_BAR;
    PG8_BAR;
#undef PG8_SA
#undef PG8_SB
#undef PG8_STAGE
#undef PG8_LDA
#undef PG8_LDB
#undef PG8_MMA
#undef PG8_WAIT_V
#undef PG8_WAIT_L
#undef PG8_BAR
#undef PG8_SCHED
#undef PG8_ABASE
#undef PG8_BBASE
}
}

struct EpiStoreBf16 {
    static constexpr bool PERM = true;
    bf16_t* O; int ldc;
    DI void operator()(const f32x4 (&acc)[2][2][4][2], const pg8::Unit& u, int wr, int wc, int fr, int fq) const {
        const int row0 = u.pm * 256 + wr * 64 + fr, col0 = u.pn * 256 + wc * 32 + 8 * fq;
#pragma unroll
        for (int ai = 0; ai < 2; ++ai)
#pragma unroll
            for (int m = 0; m < 4; ++m) { bf16_t* rowp = O + (size_t)(row0 + ai * 128 + m * 16) * ldc + col0;
#pragma unroll
                for (int bj = 0; bj < 2; ++bj) { const f32x4 v0 = acc[ai][bj][m][0], v1 = acc[ai][bj][m][1];
                    u32x4 w; w.x = pk2(v0[0], v0[1]); w.y = pk2(v0[2], v0[3]); w.z = pk2(v1[0], v1[1]); w.w = pk2(v1[2], v1[3]);
                    *(u32x4*)(rowp + bj * 128) = w; } }
    }
};
struct EpiPool {
    static constexpr bool PERM = true;
    bf16_t* O; int ldc; const float* ps;
    DI void operator()(const f32x4 (&acc)[2][2][4][2], const pg8::Unit& u, int wr, int wc, int fr, int fq) const {
        const int row0 = u.pm * 256 + wr * 64 + fr, col0 = u.pn * 256 + wc * 32 + 8 * fq;
#pragma unroll
        for (int bj = 0; bj < 2; ++bj) {
            const f32x4 p0 = *(const f32x4*)(ps + col0 + bj * 128), p1 = *(const f32x4*)(ps + col0 + bj * 128 + 4);
#pragma unroll
            for (int ai = 0; ai < 2; ++ai)
#pragma unroll
                for (int m = 0; m < 4; ++m) { bf16_t* ptr = O + (size_t)(row0 + ai * 128 + m * 16) * ldc + col0 + bj * 128;
                    const u32x4 gr = *(const u32x4*)ptr; const f32x4 v0 = acc[ai][bj][m][0], v1 = acc[ai][bj][m][1];
                    u32x4 w;
                    w.x = pk2(v0[0] * p0[0] * silu(lo_bf(gr.x)), v0[1] * p0[1] * silu(hi_bf(gr.x)));
                    w.y = pk2(v0[2] * p0[2] * silu(lo_bf(gr.y)), v0[3] * p0[3] * silu(hi_bf(gr.y)));
                    w.z = pk2(v1[0] * p1[0] * silu(lo_bf(gr.z)), v1[1] * p1[1] * silu(hi_bf(gr.z)));
                    w.w = pk2(v1[2] * p1[2] * silu(lo_bf(gr.w)), v1[3] * p1[3] * silu(hi_bf(gr.w)));
                    *(u32x4*)ptr = w; }
        }
    }
};
struct EpiOut {
    static constexpr bool PERM = false;
    float* out; float* ctxv; const float* xin; const float* cin; const float* gt0; const float* stats; const float* lg; const float* lb; int mode; int row_base;
    DI void operator()(const f32x4 (&acc)[2][2][4][2], const pg8::Unit& u, int wr, int wc, int fr, int fq) const {
        const int rowt = row_base + u.pm * 256, col0 = u.pn * 256 + wc * 32 + 4 * fq, rl = wr * 64 + fr;
        const int cd = cond_of_row(rowt);
        const float* gtp = gt0 + (size_t)cd * 6144;
        float* dbase = rowt < TL ? out + (size_t)rowt * D : ctxv + (size_t)(rowt - TL) * D;
        const float* sbase = mode ? (const float*)dbase : (rowt < TL ? xin + (size_t)rowt * D : cin + (size_t)(rowt - TL) * D);
#pragma unroll
        for (int bj = 0; bj < 2; ++bj) {
            f32x4 gv[2], gg[2], bb[2], xv[2][8];
#pragma unroll
            for (int n = 0; n < 2; ++n) {
                const int c = col0 + bj * 128 + n * 16;
                gv[n] = *(const f32x4*)(gtp + c);
                gg[n] = (f32x4){1.f, 1.f, 1.f, 1.f}; bb[n] = (f32x4){0.f, 0.f, 0.f, 0.f};
                if (mode) { gg[n] = *(const f32x4*)(lg + c); bb[n] = *(const f32x4*)(lb + c); }
#pragma unroll
                for (int q = 0; q < 8; ++q) { const int rr = rl + (q >> 2) * 128 + (q & 3) * 16; xv[n][q] = *(const f32x4*)(sbase + (size_t)rr * D + c); }
            }
#pragma unroll
            for (int n = 0; n < 2; ++n) {
                const int c = col0 + bj * 128 + n * 16;
#pragma unroll
                for (int q = 0; q < 8; ++q) {
                    const int rr = rl + (q >> 2) * 128 + (q & 3) * 16;
                    f32x4 x = xv[n][q];
                    if (mode) { const float mu = stats[2 * (rowt + rr)], rs = stats[2 * (rowt + rr) + 1]; x = (x - mu) * rs * gg[n] + bb[n]; }
                    *(f32x4*)(dbase + (size_t)rr * D + c) = ALPHA * x + gv[n] * acc[q >> 2][bj][q & 3][n];
                }
            }
        }
    }
};

DI void phase_mod(const Params& p, unsigned char* lds) {
    float* s = (float*)lds;
    float* part = s + 3 * 2048;
    float* mod = (float*)(p.ws + WS_MOD);
    const int tid = threadIdx.x;
    for (int i = tid; i < 3 * 2048; i += 512) { const int cd = i >> 11, k = i & 2047; const float v = cd < 2 ? p.in[1][cd * 2048 + k] : p.in[3][k]; s[i] = silu(v); }
    __syncthreads();
    const int cgp = tid & 15, kr = tid >> 4;
    for (int item = blockIdx.x; item < 4 * 96; item += gridDim.x) {
        const int l = item / 96, nb = item % 96;
        const float* w = p.in[4] + (size_t)l * 2048 * 6144 + nb * 64 + cgp * 4;
        f32x4 a0 = {0.f, 0.f, 0.f, 0.f}, a1 = a0, a2 = a0;
#pragma unroll 8
        for (int i = 0; i < 64; ++i) { const int k = kr + 32 * i; const f32x4 wv = *(const f32x4*)(w + (size_t)k * 6144); a0 += wv * s[k]; a1 += wv * s[2048 + k]; a2 += wv * s[4096 + k]; }
        *(f32x4*)(part + (kr * 3 + 0) * 64 + cgp * 4) = a0;
        *(f32x4*)(part + (kr * 3 + 1) * 64 + cgp * 4) = a1;
        *(f32x4*)(part + (kr * 3 + 2) * 64 + cgp * 4) = a2;
        __syncthreads();
        if (tid < 192) { const int cd = tid >> 6, n = tid & 63; float acc = p.in[5][l * 6144 + nb * 64 + n];
            for (int q = 0; q < 32; ++q) acc += part[(q * 3 + cd) * 64 + n];
            mod[(size_t)(l * 3 + cd) * 6144 + nb * 64 + n] = acc; }
        __syncthreads();
    }
}

DI void conv_tile(const float* src, int ld_src, int src_col, int k0, bf16_t* dst, int ld_dst, int n0, unsigned char* lds) {
    bf16_t* t = (bf16_t*)lds;
    const int tid = threadIdx.x;
    const int col = tid & 31, kr = tid >> 5;
#pragma unroll 4
    for (int i = 0; i < 16; ++i) { const int k = kr + 16 * i; const float v = src_col >= 0 ? src[(size_t)(k0 + k) * ld_src + src_col + col] : 0.f; t[col * 264 + k] = f2bf(v); }
    __syncthreads();
    const int n = tid >> 4, ks = (tid & 15) * 16;
    const u32x4 a = *(const u32x4*)(t + n * 264 + ks), b = *(const u32x4*)(t + n * 264 + ks + 8);
    bf16_t* o = dst + (size_t)(n0 + n) * ld_dst + k0 + ks;
    *(u32x4*)o = a; *(u32x4*)(o + 8) = b;
    __syncthreads();
}
DI int even_src_col(int n) {
    if (n >= 8224) return -1;
    if (n >= 8192) return 2048 + (n - 8192);
    const int seg = n >> 10; const int d = seg < 2 ? 0 : ((seg == 2 || seg == 7) ? 32 : (seg == 6 ? -3040 : 1056));
    return n + d;
}
DI void phase_convert(const Params& p, int layer, unsigned char* lds, int parts, int bid, int nb) {
    const int j = layer >> 1;
    bf16_t* WIN = (bf16_t*)(p.ws + win_off(layer)); bf16_t* WPOOL = (bf16_t*)(p.ws + WS_WPOOL); bf16_t* WOUT = (bf16_t*)(p.ws + wout_off(layer));
    if ((layer & 1) == 0) {
        const int nA = (parts & 1) ? 264 * 8 : 0, nB = (parts & 2) ? 64 * 8 : 0;
        for (int idx = bid; idx < nA + nB; idx += nb) {
            if (idx < nA) { const int nbk = idx >> 3, kt = idx & 7; conv_tile(p.in[8] + (size_t)j * 2048 * 8224, 8224, even_src_col(32 * nbk), 256 * kt, WIN, 2048, 32 * nbk, lds); }
            else { const int i2 = idx - nA, nbk = i2 >> 3, kt = i2 & 7; conv_tile(p.in[15] + (size_t)j * 2048 * 2048, 2048, 32 * nbk, 256 * kt, WOUT, 2048, 32 * nbk, lds); }
        }
    } else {
        const int nA = (parts & 1) ? 64 * 8 : 0, nP = (parts & 1) ? 128 : 0, nB = (parts & 2) ? 64 * 8 : 0;
        for (int idx = bid; idx < nA + nP + nB; idx += nb) {
            if (idx < nA) { const int nbk = 64 + (idx >> 3), kt = idx & 7; conv_tile(p.in[16] + (size_t)j * 2048 * 4096, 4096, 32 * nbk, 256 * kt, WIN, 2048, 32 * nbk, lds); }
            else if (idx < nA + nP) { const int i2 = idx - nA, gq = i2 >> 5, nbk = (i2 >> 1) & 15, kt = i2 & 1;
                conv_tile(p.in[17] + (size_t)(j * 4 + gq) * 512 * 512, 512, 32 * nbk, 256 * kt, WPOOL, 512, gq * 512 + 32 * nbk, lds); }
            else { const int i2 = idx - nA - nP, nbk = i2 >> 3, kt = i2 & 7; conv_tile(p.in[19] + (size_t)j * 2048 * 2048, 2048, 32 * nbk, 256 * kt, WOUT, 2048, 32 * nbk, lds); }
        }
        if (parts & 1) {
            const float* srcw = p.in[16] + (size_t)j * 2048 * 4096; bf16_t* WB = (bf16_t*)(p.ws + WS_WINB);
            for (int e = (bid * 512 + (int)threadIdx.x) * 4; e < 2048 * 2048; e += nb * 512 * 4) {
                const int k = e >> 11, c = e & 2047; const f32x4 v = *(const f32x4*)(srcw + (size_t)k * 4096 + c);
                u32x2 w; w.x = pk2(v[0], v[1]); w.y = pk2(v[2], v[3]); *(u32x2*)(WB + e) = w; }
        }
    }
}

DI void phase_norm(const Params& p, int mode, int l, int row_lo, int nrows, int bid, int nb) {
    const int lane = threadIdx.x & 63, wave = threadIdx.x >> 6;
    const int gw = bid * 8 + wave, nw = nb * 8;
    const float* mod = (const float*)(p.ws + WS_MOD);
    float* stats = (float*)(p.ws + WS_STATS);
    bf16_t* U = (bf16_t*)(p.ws + WS_U);
    const int lnext = mode == 0 ? 0 : l + 1;
    f32x4 vn[8];
    if (row_lo + gw < nrows) { const int r0 = row_lo + gw; const float* src0 = mode == 0 ? xin_row(p, r0) : (const float*)vrow(p, r0);
#pragma unroll
        for (int i = 0; i < 8; ++i) vn[i] = *(const f32x4*)(src0 + i * 256 + lane * 4); }
    for (int r = row_lo + gw; r < nrows; r += nw) {
        f32x4 v[8];
#pragma unroll
        for (int i = 0; i < 8; ++i) v[i] = vn[i];
        { const int rn = r + nw < nrows ? r + nw : r;
          const float* srcn = mode == 0 ? xin_row(p, rn) : (const float*)vrow(p, rn);
#pragma unroll
          for (int i = 0; i < 8; ++i) vn[i] = *(const f32x4*)(srcn + i * 256 + lane * 4); }
        if (mode != 0) {
            float s = 0.f;
#pragma unroll
            for (int i = 0; i < 8; ++i) s += v[i][0] + v[i][1] + v[i][2] + v[i][3];
            s = wave_sum(s); const float mu = s * (1.f / 2048.f);
            float q = 0.f;
#pragma unroll
            for (int i = 0; i < 8; ++i) { const f32x4 d = v[i] - mu; q += d[0] * d[0] + d[1] * d[1] + d[2] * d[2] + d[3] * d[3]; }
            q = wave_sum(q); const float rs = rsqrtf(q * (1.f / 2048.f) + LN_EPS);
            if (mode == 1 && lane == 0) { stats[2 * r] = mu; stats[2 * r + 1] = rs; }
            const float* lg = p.in[6] + (size_t)l * D; const float* lb = p.in[7] + (size_t)l * D;
#pragma unroll
            for (int i = 0; i < 8; ++i) { const f32x4 gg = *(const f32x4*)(lg + i * 256 + lane * 4), bb = *(const f32x4*)(lb + i * 256 + lane * 4); v[i] = (v[i] - mu) * rs * gg + bb; }
        }
        if (mode == 2) {
            float* dst = p.out + (size_t)r * D;
#pragma unroll
            for (int i = 0; i < 8; ++i) *(f32x4*)(dst + i * 256 + lane * 4) = v[i];
        } else {
            const int cd = cond_of_row(r);
            const float* sh = mod + (size_t)(lnext * 3 + cd) * 6144; const float* sc = sh + 2048;
            bf16_t* dst = U + (size_t)r * D;
#pragma unroll
            for (int i = 0; i < 8; ++i) { const int c = i * 256 + lane * 4; const f32x4 a = *(const f32x4*)(sh + c), b = *(const f32x4*)(sc + c);
                const f32x4 o = v[i] * (1.f + b) + a; u32x2 w; w.x = pk2(o[0], o[1]); w.y = pk2(o[2], o[3]); *(u32x2*)(dst + c) = w; }
        }
    }
}

template <int DIR>
DI float prep_gate_loop(const float* r_s, bf16_t* qt, bf16_t* kt, const float (&w)[16], float bias, int kk) {
    constexpr float LOG2E = 1.4426950408889634f;
    float g = 0.f;
    for (int blk = 0; blk < 4; ++blk) {
        float la[16];
#pragma unroll
        for (int i = 0; i < 16; ++i) {
            const int tt = blk * 16 + i; const int t = DIR ? 63 - tt : tt;
            const f32x4* rr = (const f32x4*)(r_s + t * 32 + DIR * 16);
            const f32x4 r0 = rr[0], r1 = rr[1], r2 = rr[2], r3 = rr[3];
            float s0 = __builtin_fmaf(r0[0], w[0], bias), s1 = r0[1] * w[1], s2 = r0[2] * w[2], s3 = r0[3] * w[3];
            s0 = __builtin_fmaf(r1[0], w[4], s0); s1 = __builtin_fmaf(r1[1], w[5], s1); s2 = __builtin_fmaf(r1[2], w[6], s2); s3 = __builtin_fmaf(r1[3], w[7], s3);
            s0 = __builtin_fmaf(r2[0], w[8], s0); s1 = __builtin_fmaf(r2[1], w[9], s1); s2 = __builtin_fmaf(r2[2], w[10], s2); s3 = __builtin_fmaf(r2[3], w[11], s3);
            s0 = __builtin_fmaf(r3[0], w[12], s0); s1 = __builtin_fmaf(r3[1], w[13], s1); s2 = __builtin_fmaf(r3[2], w[14], s2); s3 = __builtin_fmaf(r3[3], w[15], s3);
            const float pre = (s0 + s1) + (s2 + s3);
            const float ex = __builtin_amdgcn_exp2f(-fabsf(pre) * LOG2E);
            la[i] = (fminf(pre, 0.f) * LOG2E - __builtin_amdgcn_logf(1.f + ex)) * 0.0625f;
        }
#pragma unroll
        for (int i = 0; i < 16; ++i) { g += la[i]; la[i] = g; }
#pragma unroll
        for (int i = 0; i < 16; ++i) {
            const int tt = blk * 16 + i; const int t = DIR ? 63 - tt : tt;
            const float e = __builtin_amdgcn_exp2f(la[i]);
            bf16_t* qp = qt + (DIR * 64 + t) * 264 + kk; bf16_t* kp = kt + (DIR * 64 + t) * 264 + kk;
            const float qv = bf2f(*qp), kv = bf2f(*kp);
            *qp = f2bf(qv * 0.0625f * e);
            *kp = f2bf(kv * __builtin_amdgcn_rcpf(e));
        }
    }
    return __builtin_amdgcn_exp2f(g);
}

struct PrepIn { u32x4 q[4], k[4], v[4]; u32x2 rr; float w[16]; float bias; };
DI void prep_load(PrepIn& I, const Params& p, int j, int item, int tid) {
    const bf16_t* H = (const bf16_t*)(p.ws + WS_H);
    const int c = item >> 2, h = item & 3; const size_t row0 = (size_t)c * 64;
    const int dir = tid >> 8, kk = tid & 255;
    { const int t = tid >> 3, sg = tid & 7; I.rr = *(const u32x2*)(H + (row0 + t) * HE + 8192 + sg * 4); }
    const float* wgf = p.in[9]; const float* wgb = p.in[11]; const float* bgf = p.in[10]; const float* bgb = p.in[12];
    const float* wg = (dir ? wgb : wgf) + (size_t)j * 16 * 1024 + h * 256 + kk;
#pragma unroll
    for (int i = 0; i < 16; ++i) I.w[i] = wg[i * 1024];
    I.bias = (dir ? bgb : bgf)[j * 1024 + h * 256 + kk];
#pragma unroll
    for (int it = 0; it < 4; ++it) { const int idx = it * 512 + tid; const int t = idx >> 5, seg = idx & 31;
        I.q[it] = *(const u32x4*)(H + (row0 + t) * HE + 2048 + h * 256 + seg * 8);
        I.k[it] = *(const u32x4*)(H + (row0 + t) * HE + h * 256 + seg * 8);
        I.v[it] = *(const u32x4*)(H + (row0 + t) * HE + 1024 + h * 256 + seg * 8); }
}
DI void phase_prep(const Params& p, int j, unsigned char* lds) {
    float* r_s = (float*)lds;
    bf16_t* qt = (bf16_t*)(lds + 8192);
    bf16_t* kt = qt + 2 * 64 * 264;
    const bf16_t* H = (const bf16_t*)(p.ws + WS_H);
    const int tid = threadIdx.x, lane = tid & 63, wave = tid >> 6;
    const int dir = tid >> 8, kk = tid & 255;
    PrepIn I;
    if ((int)blockIdx.x < NCH * 4) prep_load(I, p, j, blockIdx.x, tid);
    for (int item = blockIdx.x; item < NCH * 4; item += gridDim.x) {
        {
            const int t = tid >> 3, sg = tid & 7;
            f32x4 o = {lo_bf(I.rr.x), hi_bf(I.rr.x), lo_bf(I.rr.y), hi_bf(I.rr.y)}; *(f32x4*)(r_s + t * 32 + sg * 4) = o;
#pragma unroll
            for (int it = 0; it < 4; ++it) { const int idx = it * 512 + tid; const int tq = idx >> 5, seg = idx & 31;
                *(u32x4*)(qt + tq * 264 + seg * 8) = I.q[it]; *(u32x4*)(qt + (64 + tq) * 264 + seg * 8) = I.q[it];
                *(u32x4*)(kt + tq * 264 + seg * 8) = I.k[it]; *(u32x4*)(kt + (64 + tq) * 264 + seg * 8) = I.k[it]; }
        }
        float w[16];
#pragma unroll
        for (int i = 0; i < 16; ++i) w[i] = I.w[i];
        const float bias = I.bias;
        u32x4 vcur[4];
#pragma unroll
        for (int it = 0; it < 4; ++it) vcur[it] = I.v[it];
        __syncthreads();
        float dlast;
        if (dir == 0) dlast = prep_gate_loop<0>(r_s, qt, kt, w, bias, kk); else dlast = prep_gate_loop<1>(r_s, qt, kt, w, bias, kk);
        ((float*)(p.ws + WS_DD))[(size_t)(item * 2 + dir) * 256 + kk] = dlast;
        { const int nitem = item + (int)gridDim.x; prep_load(I, p, j, nitem < NCH * 4 ? nitem : item, tid); }
        {
            bf16_t* KHp = (bf16_t*)(p.ws + WS_KH) + (size_t)(item * 2 + dir) * 16384;
            const int w8 = kk >> 5, r = kk & 31;
#pragma unroll
            for (int tg = 0; tg < 8; ++tg) {
                float val[8];
#pragma unroll
                for (int i = 0; i < 8; ++i) val[i] = bf2f(kt[(dir * 64 + 8 * tg + i) * 264 + kk]) * dlast;
                u32x4 pk; pk.x = pk2(val[0], val[1]); pk.y = pk2(val[2], val[3]); pk.z = pk2(val[4], val[5]); pk.w = pk2(val[6], val[7]);
                const int s = tg >> 1, hh = tg & 1;
                *(u32x4*)(KHp + ((w8 * 4 + s) * 64 + hh * 32 + r) * 8) = pk;
            }
        }
        __syncthreads();
        {
            bf16_t* QTp = (bf16_t*)(p.ws + WS_U) + (size_t)(item * 2) * 16384;
#pragma unroll
            for (int it = 0; it < 8; ++it) {
                const int idx = it * 512 + tid; const int d2 = idx >> 11, f = (idx >> 6) & 31, ln = idx & 63;
                const int w8 = f >> 2, mb = (f >> 1) & 1, s = f & 1, rr = ln & 31, hh = ln >> 5;
                const bf16_t* sp = qt + (d2 * 64 + 32 * mb + rr) * 264 + 32 * w8 + 16 * s + 4 * hh;
                const u32x2 lo = *(const u32x2*)sp, hi = *(const u32x2*)(sp + 8);
                u32x4 o; o.x = lo.x; o.y = lo.y; o.z = hi.x; o.w = hi.y;
                *(u32x4*)(QTp + (size_t)d2 * 16384 + (f * 64 + ln) * 8) = o;
            }
        }
        {
            const int d2 = wave >> 2, wd = wave & 3, fr = lane & 15, fq = lane >> 4;
            f32x4 acc[4];
#pragma unroll
            for (int nb = 0; nb < 4; ++nb) acc[nb] = (f32x4){0.f, 0.f, 0.f, 0.f};
            const bf16_t* qb = qt + (d2 * 64 + 16 * wd + fr) * 264 + 8 * fq;
            const bf16_t* kb = kt + (d2 * 64 + fr) * 264 + 8 * fq;
#pragma unroll
            for (int ks = 0; ks < 8; ++ks) {
                const bf16x8 a = *(const bf16x8*)(qb + 32 * ks);
#pragma unroll
                for (int nb = 0; nb < 4; ++nb) { const bf16x8 b = *(const bf16x8*)(kb + nb * 16 * 264 + 32 * ks); acc[nb] = __builtin_amdgcn_mfma_f32_16x16x32_bf16(a, b, acc[nb], 0, 0, 0); }
            }
            bf16_t* AMp = (bf16_t*)(p.ws + WS_AM) + (size_t)(item * 2 + d2) * 4096;
#pragma unroll
            for (int nb = 0; nb < 4; ++nb)
#pragma unroll
                for (int jx = 0; jx < 4; ++jx) {
                    const int i = 16 * wd + 4 * fq + jx, jt = 16 * nb + fr;
                    const bool keep = d2 ? (jt >= i) : (jt <= i);
                    const float val = keep ? acc[nb][jx] : 0.f;
                    const int mb = i >> 5, r = i & 31, hh = (jt >> 3) & 1, jj = jt & 7;
                    AMp[((nb * 2 + mb) * 64 + hh * 32 + r) * 8 + jj] = f2bf(val);
                }
        }
        __syncthreads();
        {
#pragma unroll
            for (int it = 0; it < 4; ++it) { const int idx = it * 512 + tid; const int t = idx >> 5, seg = idx & 31; *(u32x4*)(qt + t * 264 + seg * 8) = vcur[it]; }
        }
        __syncthreads();
        {
            bf16_t* VTp = (bf16_t*)(p.ws + WS_VT) + (size_t)item * 16384;
#pragma unroll
            for (int it = 0; it < 4; ++it) {
                const int idx = it * 512 + tid; const int f = idx >> 6, ln = idx & 63; const int sl = f >> 2, s = f & 3, rr = ln & 31, hh = ln >> 5;
                const bf16_t* sp = qt + (16 * s + 8 * hh) * 264 + 32 * sl + rr;
                unsigned e[8];
#pragma unroll
                for (int jj = 0; jj < 8; ++jj) e[jj] = sp[jj * 264];
                u32x4 o; o.x = e[0] | (e[1] << 16); o.y = e[2] | (e[3] << 16); o.z = e[4] | (e[5] << 16); o.w = e[6] | (e[7] << 16);
                *(u32x4*)(VTp + (f * 64 + ln) * 8) = o;
            }
        }
        __syncthreads();
    }
}

DI void mix_conv(const Params& p, int j, int nrows, int gw, int nw);
DI int scan_chunk(int n, int b, int dir) {
    if (n < 4) return 512 + 4 * b + (dir ? 3 - n : n);
    const int m = n - 4; return 256 * b + (dir ? 255 - m : m);
}
struct ScanFrags { bf16x8 qa[2][2], ka[4], aa[2]; u32x4 stage; };
DI void scan_load(ScanFrags& F, const unsigned char* ws, int c, int h, int dir, int sl, int w, int lane) {
    const size_t blk = (size_t)((c * 4 + h) * 2 + dir);
    const bf16_t* QT = (const bf16_t*)(ws + WS_U) + blk * 16384 + lane * 8;
    const bf16_t* KH = (const bf16_t*)(ws + WS_KH) + blk * 16384 + lane * 8;
    const bf16_t* AM = (const bf16_t*)(ws + WS_AM) + blk * 4096 + lane * 8;
#pragma unroll
    for (int mb = 0; mb < 2; ++mb)
#pragma unroll
        for (int s = 0; s < 2; ++s) F.qa[mb][s] = *(const bf16x8*)(QT + ((w * 2 + mb) * 2 + s) * 512);
#pragma unroll
    for (int s = 0; s < 4; ++s) F.ka[s] = *(const bf16x8*)(KH + (w * 4 + s) * 512);
#pragma unroll
    for (int mb = 0; mb < 2; ++mb) F.aa[mb] = w < 4 ? *(const bf16x8*)(AM + ((w * 2 + mb)) * 512) : (bf16x8){0, 0, 0, 0, 0, 0, 0, 0};
    const int tid = w * 64 + lane;
    if (tid < 256) F.stage = *(const u32x4*)((const bf16_t*)(ws + WS_VT) + (size_t)(c * 4 + h) * 16384 + sl * 2048 + tid * 8);
    else if (tid < 320) F.stage = *(const u32x4*)((const float*)(ws + WS_DD) + blk * 256 + (tid - 256) * 4);
}
constexpr int SCAN_VB_OFF = 73728, SCAN_DD_OFF = 73728 + 8192;
DI void scan_stage_store(const ScanFrags& F, LAS unsigned char* lds, int buf, int tid) {
    if (tid < 256) *(LAS u32x4*)(lds + SCAN_VB_OFF + buf * 4096 + tid * 16) = F.stage;
    else if (tid < 320) *(LAS u32x4*)(lds + SCAN_DD_OFF + buf * 1024 + (tid - 256) * 16) = F.stage;
}
DI bf16x8 pack8(const f32x16& x, int s) {
    u32x4 pk; pk.x = pk2(x[8 * s], x[8 * s + 1]); pk.y = pk2(x[8 * s + 2], x[8 * s + 3]); pk.z = pk2(x[8 * s + 4], x[8 * s + 5]); pk.w = pk2(x[8 * s + 6], x[8 * s + 7]);
    return __builtin_bit_cast(bf16x8, pk);
}
DI void phase_scan(const Params& p, LAS unsigned char* lds, unsigned char* ldsg, int j, int conv_rows, int next_layer) {
    bf16_t* H = (bf16_t*)(p.ws + WS_H);
    const int tid = threadIdx.x, lane = tid & 63, w = tid >> 6, r = lane & 31, hh = lane >> 5;
    if (blockIdx.x >= 128) {
        const int nbk = (int)gridDim.x - 128, bid = (int)blockIdx.x - 128;
        mix_conv(p, j, conv_rows, bid * 8 + (tid >> 6), nbk * 8);
        phase_convert(p, next_layer, ldsg, 3, bid, nbk);
        if (next_layer == 1) phase_convert(p, 2, ldsg, 3, bid, nbk);
        mini_barrier((unsigned*)(p.ws + WS_BAR) + 3520 + 64 * j, (unsigned)nbk);
        {
            pg8::Gemm g{(const bf16_t*)(p.ws + WS_WPOOL), (const bf16_t*)(p.ws + WS_WINB), 2048, 2048, 512, 512, 0, 2048, 1};
            pg8::StaticOrder S; S.init(g.M, g.N, nbk, bid);
            EpiStoreBf16 E{(bf16_t*)(p.ws + WS_WIN), 2048};
            pg8::gemm_phase(lds, g, S, E);
        }
        return;
    }
    for (int id = blockIdx.x; id < 128; id += gridDim.x) {
        const int xcd = id & 7, widx = id >> 3; const int scan = xcd * 2 + (widx >> 3), sl = widx & 7;
        const int b = scan >> 3, h = (scan >> 1) & 3, dir = scan & 1;
        f32x16 S;
#pragma unroll
        for (int i = 0; i < 16; ++i) S[i] = 0.f;
        ScanFrags cur, nxt, nn;
        scan_load(cur, p.ws, scan_chunk(0, b, dir), h, dir, sl, w, lane);
        scan_load(nxt, p.ws, scan_chunk(1, b, dir), h, dir, sl, w, lane);
        scan_stage_store(cur, lds, 0, tid);
        __syncthreads();
        for (int n = 0; n < 260; ++n) {
            const int c = scan_chunk(n, b, dir);
            scan_load(nn, p.ws, scan_chunk(n < 258 ? n + 2 : 259, b, dir), h, dir, sl, w, lane);
            const bf16x8 sb0 = pack8(S, 0), sb1 = pack8(S, 1);
            bf16x8 vb[4]; f32x4 dd[4];
            {
                unsigned vo = (unsigned)(SCAN_VB_OFF + (n & 1) * 4096 + lane * 16), dofs = (unsigned)(SCAN_DD_OFF + (n & 1) * 1024 + (32 * w + 4 * hh) * 4);
                asm volatile("" : "+v"(vo), "+v"(dofs));
#pragma unroll
                for (int s = 0; s < 4; ++s) { vb[s] = *(const LAS bf16x8*)(lds + vo + s * 1024); dd[s] = *(const LAS f32x4*)(lds + dofs + s * 32); }
            }
            const bf16x8 vw = (w & 3) == 0 ? vb[0] : ((w & 3) == 1 ? vb[1] : ((w & 3) == 2 ? vb[2] : vb[3]));
            bf16x8 aa0 = cur.aa[0], aa1 = cur.aa[1];
            unsigned rbo = (unsigned)(((n & 1) * 8 + w) * 4608 + r * 72 + hh * 8);
            asm volatile("" : "+v"(rbo));
            LAS unsigned char* rb = lds + rbo;
#pragma unroll
            for (int mb = 0; mb < 2; ++mb) {
                f32x16 o;
#pragma unroll
                for (int i = 0; i < 16; ++i) o[i] = 0.f;
                o = __builtin_amdgcn_mfma_f32_32x32x16_bf16(sb0, cur.qa[mb][0], o, 0, 0, 0);
                o = __builtin_amdgcn_mfma_f32_32x32x16_bf16(sb1, cur.qa[mb][1], o, 0, 0, 0);
                o = __builtin_amdgcn_mfma_f32_32x32x16_bf16(vw, mb ? aa1 : aa0, o, 0, 0, 0);
#pragma unroll
                for (int g = 0; g < 4; ++g) { u32x2 pk; pk.x = pk2(o[4 * g], o[4 * g + 1]); pk.y = pk2(o[4 * g + 2], o[4 * g + 3]);
                    *(LAS u32x2*)(rb + mb * 2304 + g * 16) = pk; }
            }
#pragma unroll
            for (int i = 0; i < 16; ++i) S[i] *= dd[i >> 2][i & 3];
#pragma unroll
            for (int s = 0; s < 4; ++s) S = __builtin_amdgcn_mfma_f32_32x32x16_bf16(cur.ka[s], vb[s], S, 0, 0, 0);
            scan_stage_store(nxt, lds, (n + 1) & 1, tid);
            __syncthreads();
            {
                const int i = tid >> 3, vq = (tid & 7) * 4;
                unsigned rpo = (unsigned)((n & 1) * 8 * 4608 + i * 72 + vq * 2);
                asm volatile("" : "+v"(rpo));
                const LAS unsigned char* rp = lds + rpo;
                float a0 = 0.f, a1 = 0.f, a2 = 0.f, a3 = 0.f;
#pragma unroll
                for (int ww = 0; ww < 8; ++ww) { const u32x2 q = *(const LAS u32x2*)(rp + ww * 4608); a0 += lo_bf(q.x); a1 += hi_bf(q.x); a2 += lo_bf(q.y); a3 += hi_bf(q.y); }
                u32x2 ov; ov.x = pk2(a0, a1); ov.y = pk2(a2, a3);
                *(u32x2*)(H + (size_t)(64 * c + i) * HE + (dir ? 2048 : 0) + h * 256 + 32 * sl + vq) = ov;
            }
            cur = nxt; nxt = nn;
        }
        __syncthreads();
    }
}

DI void phase_mix_gla(const Params& p, int j, int row_lo, int nrows, int bid, int nb) {
    bf16_t* H = (bf16_t*)(p.ws + WS_H);
    const int lane = threadIdx.x & 63, wave = threadIdx.x >> 6;
    const int gw = bid * 8 + wave, nw = nb * 8;
    const float* gnw = p.in[13] + (size_t)j * 256;
    for (int r = row_lo + gw; r < nrows; r += nw) {
        bf16_t* row = H + (size_t)r * HE;
        {
            const int c0 = lane * 16;
            float o[16];
            const u32x4 gq0 = *(const u32x4*)(row + 6144 + c0), gq1 = *(const u32x4*)(row + 6144 + c0 + 8);
#pragma unroll
            for (int q = 0; q < 2; ++q) { const u32x4 a = *(const u32x4*)(row + c0 + 8 * q), b = *(const u32x4*)(row + 2048 + c0 + 8 * q);
                o[8 * q + 0] = lo_bf(a.x) + lo_bf(b.x); o[8 * q + 1] = hi_bf(a.x) + hi_bf(b.x); o[8 * q + 2] = lo_bf(a.y) + lo_bf(b.y); o[8 * q + 3] = hi_bf(a.y) + hi_bf(b.y);
                o[8 * q + 4] = lo_bf(a.z) + lo_bf(b.z); o[8 * q + 5] = hi_bf(a.z) + hi_bf(b.z); o[8 * q + 6] = lo_bf(a.w) + lo_bf(b.w); o[8 * q + 7] = hi_bf(a.w) + hi_bf(b.w); }
            float ss = 0.f;
#pragma unroll
            for (int i = 0; i < 16; ++i) ss += o[i] * o[i];
#pragma unroll
            for (int m = 8; m > 0; m >>= 1) ss += __shfl_xor(ss, m);
            const float rs = rsqrtf(ss * (1.f / 256.f) + LN_EPS);
            const int vc = (lane & 15) * 16;
#pragma unroll
            for (int q = 0; q < 2; ++q) { const u32x4 gq = q ? gq1 : gq0;
                const f32x4 w0 = *(const f32x4*)(gnw + vc + 8 * q), w1 = *(const f32x4*)(gnw + vc + 8 * q + 4);
                u32x4 y;
                y.x = pk2(o[8 * q + 0] * rs * w0[0] * silu(lo_bf(gq.x)), o[8 * q + 1] * rs * w0[1] * silu(hi_bf(gq.x)));
                y.y = pk2(o[8 * q + 2] * rs * w0[2] * silu(lo_bf(gq.y)), o[8 * q + 3] * rs * w0[3] * silu(hi_bf(gq.y)));
                y.z = pk2(o[8 * q + 4] * rs * w1[0] * silu(lo_bf(gq.z)), o[8 * q + 5] * rs * w1[1] * silu(hi_bf(gq.z)));
                y.w = pk2(o[8 * q + 6] * rs * w1[2] * silu(lo_bf(gq.w)), o[8 * q + 7] * rs * w1[3] * silu(hi_bf(gq.w)));
                *(u32x4*)(row + 6144 + c0 + 8 * q) = y; }
        }
    }
}
DI void mix_conv(const Params& p, int j, int nrows, int gw, int nw) {
    bf16_t* H = (bf16_t*)(p.ws + WS_H);
    const int lane = threadIdx.x & 63;
    const float* cw = p.in[14] + (size_t)j * 3 * 1024;
    for (int r = gw; r < nrows; r += nw) {
        bf16_t* row = H + (size_t)r * HE;
        {
            const int c0 = lane * 16;
            const bool hasp = r < TL ? ((r & 63) != 0) : ((r & 255) != 0);
            const bool hasn = r < TL ? ((r & 63) != 63) : ((r & 255) != 255);
#pragma unroll
            for (int q = 0; q < 2; ++q) {
                const int cc = c0 + 8 * q;
                float u0[8], u1[8], u2[8];
                { const u32x4 a = *(const u32x4*)(row + 4096 + cc), b = *(const u32x4*)(row + 5120 + cc);
                  u1[0] = lo_bf(a.x) * lo_bf(b.x); u1[1] = hi_bf(a.x) * hi_bf(b.x); u1[2] = lo_bf(a.y) * lo_bf(b.y); u1[3] = hi_bf(a.y) * hi_bf(b.y);
                  u1[4] = lo_bf(a.z) * lo_bf(b.z); u1[5] = hi_bf(a.z) * hi_bf(b.z); u1[6] = lo_bf(a.w) * lo_bf(b.w); u1[7] = hi_bf(a.w) * hi_bf(b.w); }
                if (hasp) { const u32x4 a = *(const u32x4*)(row - HE + 4096 + cc), b = *(const u32x4*)(row - HE + 5120 + cc);
                  u0[0] = lo_bf(a.x) * lo_bf(b.x); u0[1] = hi_bf(a.x) * hi_bf(b.x); u0[2] = lo_bf(a.y) * lo_bf(b.y); u0[3] = hi_bf(a.y) * hi_bf(b.y);
                  u0[4] = lo_bf(a.z) * lo_bf(b.z); u0[5] = hi_bf(a.z) * hi_bf(b.z); u0[6] = lo_bf(a.w) * lo_bf(b.w); u0[7] = hi_bf(a.w) * hi_bf(b.w); }
                else {
#pragma unroll
                    for (int i = 0; i < 8; ++i) u0[i] = 0.f; }
                if (hasn) { const u32x4 a = *(const u32x4*)(row + HE + 4096 + cc), b = *(const u32x4*)(row + HE + 5120 + cc);
                  u2[0] = lo_bf(a.x) * lo_bf(b.x); u2[1] = hi_bf(a.x) * hi_bf(b.x); u2[2] = lo_bf(a.y) * lo_bf(b.y); u2[3] = hi_bf(a.y) * hi_bf(b.y);
                  u2[4] = lo_bf(a.z) * lo_bf(b.z); u2[5] = hi_bf(a.z) * hi_bf(b.z); u2[6] = lo_bf(a.w) * lo_bf(b.w); u2[7] = hi_bf(a.w) * hi_bf(b.w); }
                else {
#pragma unroll
                    for (int i = 0; i < 8; ++i) u2[i] = 0.f; }
                const u32x4 ab = *(const u32x4*)(row + 3072 + cc), ga = *(const u32x4*)(row + 7168 + cc);
                float abf[8] = {lo_bf(ab.x), hi_bf(ab.x), lo_bf(ab.y), hi_bf(ab.y), lo_bf(ab.z), hi_bf(ab.z), lo_bf(ab.w), hi_bf(ab.w)};
                float gaf[8] = {lo_bf(ga.x), hi_bf(ga.x), lo_bf(ga.y), hi_bf(ga.y), lo_bf(ga.z), hi_bf(ga.z), lo_bf(ga.w), hi_bf(ga.w)};
                float y[8];
#pragma unroll
                for (int hq = 0; hq < 2; ++hq) {
                    const f32x4 w0 = *(const f32x4*)(cw + cc + 4 * hq), w1 = *(const f32x4*)(cw + 1024 + cc + 4 * hq), w2 = *(const f32x4*)(cw + 2048 + cc + 4 * hq);
#pragma unroll
                    for (int i = 0; i < 4; ++i) { const int e = 4 * hq + i; y[e] = abf[e] * (w0[i] * u0[e] + w1[i] * u1[e] + w2[i] * u2[e]) * silu(gaf[e]); }
                }
                u32x4 yo; yo.x = pk2(y[0], y[1]); yo.y = pk2(y[2], y[3]); yo.z = pk2(y[4], y[5]); yo.w = pk2(y[6], y[7]);
                *(u32x4*)(row + 7168 + cc) = yo;
            }
        }
    }
}

template <int WIN>
DI void pool_item(bf16_t* H, const float* ps, int r, int gq, int lane) {
    int pos, stride, base;
    if (r < TL) { const int t = r & 16383; pos = t >> 6; stride = 64; base = r - pos * 64; }
    else { const int t = (r - TL) & 255; pos = t; stride = 1; base = r - pos; }
    const int col = gq * 512 + lane * 8;
    u32x4 v[WIN];
#pragma unroll
    for (int i = 0; i < WIN; ++i) { int q = pos - WIN / 2 + i; q = q < 0 ? 0 : (q > 255 ? 255 : q); v[i] = *(const u32x4*)(H + (size_t)(base + q * stride) * HO + col); }
    bf16_t* gp = H + (size_t)r * HO + 2048 + col;
    const u32x4 gt = *(const u32x4*)gp;
    const f32x4 p0 = *(const f32x4*)(ps + col), p1 = *(const f32x4*)(ps + col + 4);
    float acc[8];
#pragma unroll
    for (int i = 0; i < 8; ++i) acc[i] = 0.f;
#pragma unroll
    for (int i = 0; i < WIN; ++i) { const int q = pos - WIN / 2 + i; const float m = (q >= 0 && q < 256) ? 1.f : 0.f;
        acc[0] += m * lo_bf(v[i].x); acc[1] += m * hi_bf(v[i].x); acc[2] += m * lo_bf(v[i].y); acc[3] += m * hi_bf(v[i].y);
        acc[4] += m * lo_bf(v[i].z); acc[5] += m * hi_bf(v[i].z); acc[6] += m * lo_bf(v[i].w); acc[7] += m * hi_bf(v[i].w); }
    int lo = pos - WIN / 2, hi = pos + WIN - WIN / 2; lo = lo < 0 ? 0 : lo; hi = hi > 256 ? 256 : hi;
    const float inv = 1.f / (float)(hi - lo);
    const u32x4 s = v[WIN / 2];
    u32x4 o;
    o.x = pk2((acc[0] * inv - lo_bf(s.x)) * p0[0] * silu(lo_bf(gt.x)), (acc[1] * inv - hi_bf(s.x)) * p0[1] * silu(hi_bf(gt.x)));
    o.y = pk2((acc[2] * inv - lo_bf(s.y)) * p0[2] * silu(lo_bf(gt.y)), (acc[3] * inv - hi_bf(s.y)) * p0[3] * silu(hi_bf(gt.y)));
    o.z = pk2((acc[4] * inv - lo_bf(s.z)) * p1[0] * silu(lo_bf(gt.z)), (acc[5] * inv - hi_bf(s.z)) * p1[1] * silu(hi_bf(gt.z)));
    o.w = pk2((acc[6] * inv - lo_bf(s.w)) * p1[2] * silu(lo_bf(gt.w)), (acc[7] * inv - hi_bf(s.w)) * p1[3] * silu(hi_bf(gt.w)));
    *(u32x4*)gp = o;
}
DI void phase_poolmix(const Params& p, int j, int row_lo, int nrows, int bid, int nb) {
    bf16_t* H = (bf16_t*)(p.ws + WS_H);
    const float* Z = p.in[18] + (size_t)j * D;
    const int lane = threadIdx.x & 63, wave = threadIdx.x >> 6;
    const int gw = bid * 8 + wave, nw = nb * 8;
    for (int it = row_lo * 4 + gw; it < nrows * 4; it += nw) {
        const int r = it >> 2, gq = it & 3;
        if (gq == 0) pool_item<2>(H, Z, r, gq, lane);
        else if (gq == 1) pool_item<4>(H, Z, r, gq, lane);
        else if (gq == 2) pool_item<8>(H, Z, r, gq, lane);
        else pool_item<16>(H, Z, r, gq, lane);
    }
}


#define XB_TMO      128
#define XB_XCNT(j)  (256  + 64 * (j))
#define XB_XSUB(j)  (1280 + 64 * (j))
#define XB_XGEN(j)  (2304 + 64 * (j))
#define XB_TOP      3328
#define XB_TOPGEN   3392
#define XCD_BAR_WORDS 3456
#define XB_SPIN_CAP (1u << 18)
DI unsigned xb_xcc_id() { return (unsigned)__builtin_amdgcn_s_getreg((3 << 11) | 20) & 0xFu; }
#define XB_SPIN(cond, bar) do { unsigned _sp = 0; while (cond) { __builtin_amdgcn_s_sleep(1); \
    if ((++_sp & 255u) == 0u) { if (xb_ld(&(bar)[XB_TMO])) break; if (_sp > XB_SPIN_CAP) { atomicAdd(&(bar)[XB_TMO], 1u); break; } } } } while (0)
struct XcdBarrier { unsigned* bar; unsigned x; volatile LAS unsigned* st; };
DI XcdBarrier xcd_barrier_post(unsigned* bar, volatile LAS unsigned* st) {
    XcdBarrier b; b.bar = bar; b.x = xb_xcc_id(); b.st = st;
    if (threadIdx.x == 0) (void)xb_add(&bar[XB_XCNT(b.x)], 1u);
    return b;
}
DI void xcd_barrier_complete(unsigned* bar, unsigned x, unsigned& nloc, unsigned& nx) {
    const unsigned G = gridDim.x * gridDim.y * gridDim.z;
    unsigned sum, cnt, mine, sp = 0u;
    for (;;) {
        sum = 0u; cnt = 0u; mine = 0u;
#pragma unroll
        for (unsigned j = 0; j < 16; ++j) { const unsigned c = xb_ld(&bar[XB_XCNT(j)]); sum += c; cnt += (c > 0u) ? 1u : 0u; mine = (j == x) ? c : mine; }
        if (sum == G) break;
        __builtin_amdgcn_s_sleep(1);
        if ((++sp & 255u) == 0u) { if (xb_ld(&bar[XB_TMO])) break; if (sp > XB_SPIN_CAP) { atomicAdd(&bar[XB_TMO], 1u); break; } }
    }
    nloc = mine > 0u ? mine : 1u; nx = cnt > 0u ? cnt : 1u;
}
DI void xcd_barrier(const XcdBarrier& b) {
    asm volatile("s_waitcnt vmcnt(0)" ::: "memory");
    __syncthreads();
    if (threadIdx.x == 0) {
        unsigned* bar = b.bar;
        __builtin_amdgcn_s_waitcnt(0);
        unsigned nloc = b.st[0], nx = b.st[1];
        if (nloc == 0u) { xcd_barrier_complete(bar, b.x, nloc, nx); b.st[0] = nloc; b.st[1] = nx; }
        const unsigned old = xb_add(&bar[XB_XSUB(b.x)], 1u);
        const unsigned gen = old / nloc;
        if (old + 1u == (gen + 1u) * nloc) {
            __builtin_amdgcn_fence(__ATOMIC_RELEASE, "agent");
            asm volatile("s_waitcnt vmcnt(0)" ::: "memory");
            const unsigned og = xb_add(&bar[XB_TOP], 1u);
            const unsigned tg = og / nx;
            if (og + 1u == (tg + 1u) * nx) xb_add(&bar[XB_TOPGEN], 1u);
            else XB_SPIN(xb_ld(&bar[XB_TOPGEN]) == tg, bar);
            __builtin_amdgcn_fence(__ATOMIC_ACQUIRE, "agent");
            xb_add(&bar[XB_XGEN(b.x)], 1u);
            asm volatile("s_waitcnt vmcnt(0)" ::: "memory");
        } else {
            XB_SPIN(xb_ld(&bar[XB_XGEN(b.x)]) == gen, bar);
            __builtin_amdgcn_fence(__ATOMIC_ACQUIRE, "agent");
            asm volatile("s_waitcnt vmcnt(0)" ::: "memory");
        }
    }
    __syncthreads();
}

DI void gemm_in_even(const Params& p, int layer, LAS unsigned char* lds) {
    pg8::Gemm g{(const bf16_t*)(p.ws + WS_U), (const bf16_t*)(p.ws + win_off(layer)), R, HE, D, D, 0, D, 0};
    pg8::StaticOrder S; S.init(g.M, g.N, (int)gridDim.x, (int)blockIdx.x);
    EpiStoreBf16 E{(bf16_t*)(p.ws + WS_H), HE};
    pg8::gemm_phase(lds, g, S, E);
}
DI void gemm_in_odd(const Params& p, int M, LAS unsigned char* lds) {
    pg8::Gemm g{(const bf16_t*)(p.ws + WS_U), (const bf16_t*)(p.ws + WS_WIN), M, HO, D, D, 0, D, 0};
    pg8::StaticOrder S; S.init(g.M, g.N, (int)gridDim.x, (int)blockIdx.x);
    EpiStoreBf16 E{(bf16_t*)(p.ws + WS_H), HO};
    pg8::gemm_phase(lds, g, S, E);
}
DI void gemm_out(const Params& p, int layer, int row_base, int M, int bid, int nb, LAS unsigned char* lds) {
    const bool even = (layer & 1) == 0;
    const int ldh = even ? HE : HO;
    pg8::Gemm g{(const bf16_t*)(p.ws + WS_H) + (size_t)row_base * ldh + (even ? 6144 : 2048), (const bf16_t*)(p.ws + wout_off(layer)), M, D, D, ldh, 0, D, 0};
    pg8::StaticOrder S; S.init(g.M, g.N, nb, bid);
    const int lp = layer > 0 ? layer - 1 : 0;
    EpiOut E{p.out, (float*)(p.ws + WS_CTXV), p.in[0], p.in[2], (const float*)(p.ws + WS_MOD) + (size_t)(layer * 3) * 6144 + 4096, (const float*)(p.ws + WS_STATS),
             p.in[6] + (size_t)lp * D, p.in[7] + (size_t)lp * D, layer > 0 ? 1 : 0, row_base};
    pg8::gemm_phase(lds, g, S, E);
}
DI void phase5(const Params& p, LAS unsigned char* lds3) {
    const int bid = (int)blockIdx.x, nb = (int)gridDim.x;
    if (bid < 16) { phase_mix_gla(p, 0, TL, R, bid, 16); mini_barrier((unsigned*)(p.ws + WS_BAR) + 3648, 16u); gemm_out(p, 0, TL, TC, bid, 16, lds3); }
    else phase_mix_gla(p, 0, 0, TL, bid - 16, nb - 16);
}
DI void phase7(const Params& p, LAS unsigned char* lds3) {
    const int bid = (int)blockIdx.x, nb = (int)gridDim.x;
    if (bid < 32) {
        phase_norm(p, 1, 0, TL, R, bid, 32); mini_barrier((unsigned*)(p.ws + WS_BAR) + 3712, 32u);
        pg8::Gemm g{(const bf16_t*)(p.ws + WS_U) + (size_t)TL * D, (const bf16_t*)(p.ws + WS_WIN), TC, HO, D, D, 0, D, 0};
        pg8::StaticOrder S; S.init(g.M, g.N, 32, bid);
        EpiStoreBf16 E{(bf16_t*)(p.ws + WS_H) + (size_t)TL * HO, HO};
        pg8::gemm_phase(lds3, g, S, E);
    } else phase_norm(p, 1, 0, 0, TL, bid - 32, nb - 32);
}
DI void phase9(const Params& p, LAS unsigned char* lds3) {
    const int bid = (int)blockIdx.x, nb = (int)gridDim.x;
    if (bid < 16) { phase_poolmix(p, 0, TL, R, bid, 16); mini_barrier((unsigned*)(p.ws + WS_BAR) + 3776, 16u); gemm_out(p, 1, TL, TC, bid, 16, lds3); }
    else phase_poolmix(p, 0, 0, TL, bid - 16, nb - 16);
}

DI Params load_params() {
#if defined(__HIP_DEVICE_COMPILE__)
    typedef const Params __attribute__((address_space(4))) CParams;
    CParams* kp = (CParams*)__builtin_amdgcn_kernarg_segment_ptr(); asm volatile("" : "+s"(kp)); return *kp;
#else
    return Params{};
#endif
}
__global__ void __launch_bounds__(512, 2) mega(Params p0) {
    extern __shared__ __attribute__((aligned(16))) unsigned char shm[];
    LAS unsigned char* lds3 = (LAS unsigned char*)shm;
    const int ph_lo = p0.ph_lo, ph_hi = p0.ph_hi;
    volatile LAS unsigned* xst = (volatile LAS unsigned*)(lds3 + LDS_MAIN);
    if (threadIdx.x < 4) xst[threadIdx.x] = 0u;
    __syncthreads();
    const XcdBarrier xb = xcd_barrier_post((unsigned*)(p0.ws + WS_BAR), xst);
#define PH(k, ...) if (ph_lo <= (k) && (k) < ph_hi) { if ((k) > ph_lo) { if (ph_hi == 0x7fffffff) cg::this_grid().sync(); else xcd_barrier(xb); } \
        const Params p = load_params(); __VA_ARGS__; if ((k) == DUP) { xcd_barrier(xb); __VA_ARGS__; } }
    PH(0, phase_mod(p, shm); phase_convert(p, 0, shm, 3, (int)blockIdx.x, (int)gridDim.x))
    PH(1, phase_norm(p, 0, 0, 0, R, (int)blockIdx.x, (int)gridDim.x))
    PH(2, gemm_in_even(p, 0, lds3))
    PH(3, phase_prep(p, 0, shm))
    PH(4, phase_scan(p, lds3, shm, 0, R, 1))
    PH(5, phase5(p, lds3))
    PH(6, gemm_out(p, 0, 0, TL, (int)blockIdx.x, (int)gridDim.x, lds3))
    PH(7, phase7(p, lds3))
    PH(8, gemm_in_odd(p, TL, lds3))
    PH(9, phase9(p, lds3))
    PH(11, gemm_out(p, 1, 0, TL, (int)blockIdx.x, (int)gridDim.x, lds3))
    PH(12, phase_norm(p, 1, 1, 0, R, (int)blockIdx.x, (int)gridDim.x))
    PH(13, gemm_in_even(p, 2, lds3))
    PH(14, phase_prep(p, 1, shm))
    PH(15, phase_scan(p, lds3, shm, 1, TL, 3))
    PH(16, phase_mix_gla(p, 1, 0, TL, (int)blockIdx.x, (int)gridDim.x))
    PH(17, gemm_out(p, 2, 0, TL, (int)blockIdx.x, (int)gridDim.x, lds3))
    PH(18, phase_norm(p, 1, 2, 0, TL, (int)blockIdx.x, (int)gridDim.x))
    PH(19, gemm_in_odd(p, TL, lds3))
    PH(20, phase_poolmix(p, 1, 0, TL, (int)blockIdx.x, (int)gridDim.x))
    PH(22, gemm_out(p, 3, 0, TL, (int)blockIdx.x, (int)gridDim.x, lds3))
    PH(23, phase_norm(p, 2, 3, 0, TL, (int)blockIdx.x, (int)gridDim.x))
#undef PH
}

extern "C" void kernel_launch(void* const* d_in, const int* in_sizes, int n_in, void* d_out, int out_size, void* d_ws, size_t ws_size, hipStream_t stream) {
    static int grid = 0;
    if (grid == 0) {
        if (n_in != 20 || ws_size < WS_END) { fprintf(stderr, "kernel_launch: unexpected n_in %d / ws_size %zu\n", n_in, ws_size); grid = -1; return; }
        int dev = 0, cus = 0, per_cu = 0;
        hipGetDevice(&dev);
        hipDeviceGetAttribute(&cus, hipDeviceAttributeMultiprocessorCount, dev);
        if (hipFuncSetAttribute((const void*)mega, hipFuncAttributeMaxDynamicSharedMemorySize, LDS_BYTES) != hipSuccess) { fprintf(stderr, "hipFuncSetAttribute failed\n"); grid = -1; return; }
        if (hipOccupancyMaxActiveBlocksPerMultiprocessor(&per_cu, (const void*)mega, 512, LDS_BYTES) != hipSuccess || per_cu < 1) { fprintf(stderr, "occupancy query: %d\n", per_cu); per_cu = 1; }
        (void)hipGetLastError();
        grid = cus * per_cu;
    }
    if (grid < 0) return;
    Params p{};
    for (int i = 0; i < 20; ++i) p.in[i] = (const float*)d_in[i];
    p.out = (float*)d_out; p.ws = (unsigned char*)d_ws;
    (void)hipMemsetAsync((char*)d_ws + WS_BAR, 0, 4096 * 4, stream);
#if MULTI
    for (int ph = 0; ph < NPHASE; ++ph) {
        p.ph_lo = ph; p.ph_hi = ph + 1;
        hipLaunchKernelGGL(mega, dim3(grid), dim3(512), LDS_BYTES, stream, p);
    }
#else
    p.ph_lo = 0; p.ph_hi = NPHASE;
    void* args[] = {&p};
    hipError_t e = hipLaunchCooperativeKernel((const void*)mega, dim3(grid), dim3(512), args, LDS_BYTES, stream);
    if (e != hipSuccess) fprintf(stderr, "cooperative launch failed: %s (grid %d)\n", hipGetErrorString(e), grid);
#endif
}
```

```cpp
#include <hip/hip_runtime.h>
#include <hip/hip_cooperative_groups.h>
#include <cstdio>
namespace cg = cooperative_groups;

#ifndef MULTI
#define MULTI 0
#endif
#define DUP -1

#define DI __device__ __forceinline__
#define LAS __attribute__((address_space(3)))
typedef unsigned short bf16_t;
typedef short bf16x8 __attribute__((ext_vector_type(8)));
typedef float f32x2 __attribute__((ext_vector_type(2)));
typedef float f32x4 __attribute__((ext_vector_type(4)));
typedef float f32x16 __attribute__((ext_vector_type(16)));
typedef unsigned u32x2 __attribute__((ext_vector_type(2)));
typedef unsigned u32x4 __attribute__((ext_vector_type(4)));
typedef __bf16 bfv2 __attribute__((ext_vector_type(2)));

constexpr int D = 2048, TL = 32768, TC = 512, R = TL + TC, NCH = R / 64;
constexpr int HE = 8448, HO = 4096;
constexpr float ALPHA = 1.6817928305074290f;
constexpr float LN_EPS = 1e-5f;
constexpr size_t MB = 1u << 20;
constexpr size_t WS_MOD = 0, WS_STATS = 1 * MB, WS_CTXV = 2 * MB, WS_WIN = 6 * MB, WS_WPOOL = 40 * MB, WS_WOUT = 42 * MB,
                 WS_U = 50 * MB, WS_H = 180 * MB, WS_KH = 717 * MB, WS_AM = 847 * MB, WS_DD = 880 * MB, WS_VT = 885 * MB, WS_BAR = 950 * MB, WS_WINB = 952 * MB, WS_WOUT_B = 960 * MB, WS_WIN_B = 968 * MB, WS_WOUT_C = 1002 * MB, WS_END = 1010 * MB;
constexpr int LDS_MAIN = 143360, LDS_BYTES = LDS_MAIN + 16;
constexpr int NPHASE = 24;

struct Params {
    const float* in[20];
    float* out;
    unsigned char* ws;
    int ph_lo, ph_hi;
};

DI float bf2f(bf16_t b) { return __uint_as_float(((unsigned)b) << 16); }
DI unsigned pk2(float lo, float hi) { f32x2 v = {lo, hi}; bfv2 b = __builtin_convertvector(v, bfv2); return __builtin_bit_cast(unsigned, b); }
DI bf16_t f2bf(float f) { return (bf16_t)(pk2(f, 0.f) & 0xffffu); }
DI float lo_bf(unsigned u) { return __uint_as_float(u << 16); }
DI float hi_bf(unsigned u) { return __uint_as_float(u & 0xffff0000u); }
DI float silu(float x) { return x / (1.f + __expf(-x)); }
DI float wave_sum(float v) {
#pragma unroll
    for (int o = 32; o > 0; o >>= 1) v += __shfl_xor(v, o);
    return v;
}
DI unsigned xb_ld(unsigned* p)              { return __hip_atomic_load(p, __ATOMIC_RELAXED, __HIP_MEMORY_SCOPE_AGENT); }
DI unsigned xb_add(unsigned* p, unsigned v) { return __hip_atomic_fetch_add(p, v, __ATOMIC_RELAXED, __HIP_MEMORY_SCOPE_AGENT); }
DI size_t win_off(int layer) { return layer == 2 ? WS_WIN_B : WS_WIN; }
DI size_t wout_off(int layer) { return layer == 0 ? WS_WOUT : (layer == 2 ? WS_WOUT_C : WS_WOUT_B); }
DI void mini_barrier(unsigned* cnt, unsigned expected) {
    asm volatile("s_waitcnt vmcnt(0)" ::: "memory");
    __syncthreads();
    if (threadIdx.x == 0) {
        __builtin_amdgcn_fence(__ATOMIC_RELEASE, "agent");
        asm volatile("s_waitcnt vmcnt(0)" ::: "memory");
        (void)xb_add(cnt, 1u);
        unsigned sp = 0; while (xb_ld(cnt) < expected) { __builtin_amdgcn_s_sleep(1); if (++sp > (1u << 22)) break; }
        __builtin_amdgcn_fence(__ATOMIC_ACQUIRE, "agent");
        asm volatile("s_waitcnt vmcnt(0)" ::: "memory");
    }
    __syncthreads();
}
DI int cond_of_row(int r) { return r < 16384 ? 0 : (r < 32768 ? 1 : 2); }
DI float* vrow(const Params& p, int r) { return r < TL ? p.out + (size_t)r * D : (float*)(p.ws + WS_CTXV) + (size_t)(r - TL) * D; }
DI const float* xin_row(const Params& p, int r) { return r < TL ? p.in[0] + (size_t)r * D : p.in[2] + (size_t)(r - TL) * D; }

namespace pg8 {
constexpr int BM = 256, BK = 64, HALF = 128, HTB = HALF * BK * 2, STAGE_BYTES = 8 * HTB, NXCD = 8, WGM = 8;
DI int lds_byte(int r, int c) { const int st = (r >> 4) * 2 + (c >> 5), rr = r & 15, cc = c & 31, ob = rr * 64 + cc * 2; return st * 1024 + (ob ^ (((ob >> 9) & 1) << 5)); }
DI void stage_rc(int b, int& Rr, int& C) { const int st = b / 1024, sb = b % 1024, swz = sb ^ (((sb >> 9) & 1) << 5); Rr = (st >> 1) * 16 + swz / 64; C = (st & 1) * 32 + (swz % 64) / 2; }
DI int perm32(int rho) { const int n = rho >> 4, i = rho & 15; return 8 * (i >> 2) + 4 * n + (i & 3); }
struct Unit { int pm, pn; };
struct Gemm { const bf16_t* A; const bf16_t* Bt; int M, N, K, lda, agroup, ldb, bgroup; };
struct StaticOrder {
    int nM, nN, nwg, G, c;
    DI void init(int M, int N, int G_, int c_) { nM = M / BM; nN = N / BM; nwg = nM * nN; G = G_; c = c_; }
    DI bool next(int i, Unit& u) const {
        const long L = (long)i * G + c; if (L >= nwg) return false;
        int wgid = (int)L; { const int q = nwg / NXCD, r = nwg % NXCD, xcd = wgid % NXCD, off = wgid / NXCD; wgid = (xcd < r ? xcd * (q + 1) : r * (q + 1) + (xcd - r) * q) + off; }
        const int nig = WGM * nN, gid = wgid / nig, fm = gid * WGM, gsz = (nM - fm) < WGM ? (nM - fm) : WGM;
        u.pm = fm + ((wgid % nig) % gsz); u.pn = (wgid % nig) / gsz; return true;
    }
};

template <class Epi>
DI void gemm_phase(LAS unsigned char* lds, const Gemm g, const StaticOrder& S, const Epi& E) {
    const int tid = threadIdx.x, wid = __builtin_amdgcn_readfirstlane(tid >> 6), lane = tid & 63, wr = wid >> 2, wc = wid & 3, fr = lane & 15, fq = lane >> 4;
    const int K = g.K, nt = K / BK, lda = g.lda, ldb = g.ldb;
    unsigned voffA[2], voffB[2];
#pragma unroll
    for (int i = 0; i < 2; ++i) { int Rr, C; stage_rc(tid * 16 + i * 8192, Rr, C); const int Rb = Epi::PERM ? ((Rr & ~31) + perm32(Rr & 31)) : Rr;
        voffA[i] = (unsigned)(Rr * lda + C) * 2u; voffB[i] = (unsigned)(Rb * ldb + C) * 2u; }
    const size_t kstep = (size_t)(BK * 2);
    const size_t hstepA = (size_t)HALF * lda * 2, hstepB = (size_t)HALF * ldb * 2;
    const size_t tstepA = 2 * hstepA, tstepB = 2 * hstepB;
    const unsigned ldsw = (unsigned)wid * 1024u;
    const int aoff = lds_byte(wr * 64 + fr, fq * 8), boff = lds_byte(wc * 32 + fr, fq * 8);
#define PG8_SA(b, h) (((b) * 2 + (h)) * HTB)
#define PG8_SB(b, h) ((4 + (b) * 2 + (h)) * HTB)
#define PG8_STAGE(bufoff, gbase, voff) do { _Pragma("unroll") for (int _i = 0; _i < 2; ++_i) \
        __builtin_amdgcn_global_load_lds((const unsigned*)((const char*)(gbase) + (voff)[_i]), (LAS unsigned*)(lds + (bufoff) + ldsw + _i * 8192), 16, 0, 0); } while (0)
#define PG8_LDA(dst, b, h) do { _Pragma("unroll") for (int m = 0; m < 4; ++m) _Pragma("unroll") for (int k = 0; k < 2; ++k) dst[m][k] = *(const LAS bf16x8*)(lds + PG8_SA(b, h) + aoff + m * 2048 + k * 1024); } while (0)
#define PG8_LDB(dst, b, h) do { _Pragma("unroll") for (int n = 0; n < 2; ++n) _Pragma("unroll") for (int k = 0; k < 2; ++k) dst[n][k] = *(const LAS bf16x8*)(lds + PG8_SB(b, h) + boff + n * 2048 + k * 1024); } while (0)
#define PG8_MMA(ai, bj, At, Bt) do { __builtin_amdgcn_s_setprio(1); _Pragma("unroll") for (int m = 0; m < 4; ++m) _Pragma("unroll") for (int n = 0; n < 2; ++n) _Pragma("unroll") for (int k = 0; k < 2; ++k) \
        acc[ai][bj][m][n] = __builtin_amdgcn_mfma_f32_16x16x32_bf16(Bt[n][k], At[m][k], acc[ai][bj][m][n], 0, 0, 0); __builtin_amdgcn_s_setprio(0); } while (0)
#define PG8_WAIT_V(n) asm volatile("s_waitcnt vmcnt(" #n ")" ::: "memory")
#define PG8_WAIT_L(n) asm volatile("s_waitcnt lgkmcnt(" #n ")" ::: "memory")
#define PG8_BAR __builtin_amdgcn_s_barrier()
#define PG8_SCHED __builtin_amdgcn_sched_barrier(0)
#define PG8_ABASE(u) ((const char*)g.A + (size_t)(u).pm * tstepA + (g.agroup ? (size_t)((u).pn >> 1) * 1024 : (size_t)0))
#define PG8_BBASE(u) ((const char*)g.Bt + (size_t)(u).pn * tstepB + (g.bgroup ? (size_t)((u).pm >> 1) * 1024 : (size_t)0))
    Unit cur, nxt; int ui = 0;
    if (!S.next(0, cur)) return;
    f32x4 acc[2][2][4][2];
#pragma unroll
    for (int a = 0; a < 2; ++a)
#pragma unroll
        for (int b = 0; b < 2; ++b)
#pragma unroll
            for (int m = 0; m < 4; ++m)
#pragma unroll
                for (int n = 0; n < 2; ++n) acc[a][b][m][n] = (f32x4){0.f, 0.f, 0.f, 0.f};
    bf16x8 At[4][2], B0[2][2], B1[2][2];
    const char* cA = PG8_ABASE(cur); const char* cB = PG8_BBASE(cur);
    PG8_STAGE(PG8_SB(0, 0), cB, voffB); PG8_STAGE(PG8_SA(0, 0), cA, voffA); PG8_STAGE(PG8_SB(0, 1), cB + hstepB, voffB); PG8_STAGE(PG8_SA(0, 1), cA + hstepA, voffA);
    if (wr == 1) PG8_BAR;
    PG8_WAIT_V(4); PG8_BAR;
    PG8_STAGE(PG8_SB(1, 0), cB + kstep, voffB); PG8_STAGE(PG8_SA(1, 0), cA + kstep, voffA); PG8_STAGE(PG8_SB(1, 1), cB + hstepB + kstep, voffB);
    PG8_WAIT_V(6); PG8_BAR;
    for (;;) {
        const bool has_next = S.next(ui + 1, nxt);
        const char* nA = has_next ? PG8_ABASE(nxt) : cA; const char* nB = has_next ? PG8_BBASE(nxt) : cB;
        for (int t = 0; t < nt; t += 2) {
            const bool last = (t == nt - 2);
            const char* a1 = cA + (size_t)(t + 1) * kstep;
            const char* a2 = last ? nA : cA + (size_t)(t + 2) * kstep; const char* b2 = last ? nB : cB + (size_t)(t + 2) * kstep;
            const char* a3 = a2 + kstep; const char* b3 = b2 + kstep;
            PG8_LDB(B0, 0, 0); PG8_SCHED; PG8_LDA(At, 0, 0); PG8_STAGE(PG8_SA(1, 1), a1 + hstepA, voffA);
            PG8_WAIT_L(8); PG8_BAR; PG8_WAIT_L(0); PG8_MMA(0, 0, At, B0); PG8_BAR; PG8_SCHED;
            PG8_LDB(B1, 0, 1); PG8_STAGE(PG8_SB(0, 0), b2, voffB);
            PG8_BAR; PG8_WAIT_L(0); PG8_MMA(0, 1, At, B1); PG8_BAR;
            PG8_LDA(At, 0, 1); PG8_STAGE(PG8_SA(0, 0), a2, voffA);
            PG8_BAR; PG8_WAIT_L(0); PG8_MMA(1, 0, At, B0); PG8_BAR; PG8_SCHED;
            PG8_STAGE(PG8_SB(0, 1), b2 + hstepB, voffB);
            PG8_WAIT_V(6); PG8_BAR; PG8_MMA(1, 1, At, B1); PG8_BAR;
            PG8_LDB(B0, 1, 0); PG8_SCHED; PG8_LDA(At, 1, 0); PG8_STAGE(PG8_SA(0, 1), a2 + hstepA, voffA);
            PG8_WAIT_L(8); PG8_BAR; PG8_WAIT_L(0); PG8_MMA(0, 0, At, B0); PG8_BAR; PG8_SCHED;
            PG8_LDB(B1, 1, 1); PG8_STAGE(PG8_SB(1, 0), b3, voffB);
            PG8_BAR; PG8_WAIT_L(0); PG8_MMA(0, 1, At, B1); PG8_BAR;
            PG8_LDA(At, 1, 1); PG8_STAGE(PG8_SA(1, 0), a3, voffA);
            PG8_BAR; PG8_WAIT_L(0); PG8_MMA(1, 0, At, B0); PG8_BAR; PG8_SCHED;
            PG8_STAGE(PG8_SB(1, 1), b3 + hstepB, voffB);
            PG8_WAIT_V(6); PG8_BAR; PG8_MMA(1, 1, At, B1); PG8_BAR;
        }
        E(acc, cur, wr, wc, fr, fq);
        if (!has_next) break;
#pragma unroll
        for (int a = 0; a < 2; ++a)
#pragma unroll
            for (int b = 0; b < 2; ++b)
#pragma unroll
                for (int m = 0; m < 4; ++m)
#pragma unroll
                    for (int n = 0; n < 2; ++n) acc[a][b][m][n] = (f32x4){0.f, 0.f, 0.f, 0.f};
        cur = nxt; cA = nA; cB = nB; ++ui;
    }
    PG8_WAIT_V(0);
    if (wr == 0) PG8_BAR;
    PG8_BAR;
#undef PG8_SA
#undef PG8_SB
#undef PG8_STAGE
#undef PG8_LDA
#undef PG8_LDB
#undef PG8_MMA
#undef PG8_WAIT_V
#undef PG8_WAIT_L
#undef PG8_BAR
#undef PG8_SCHED
#undef PG8_ABASE
#undef PG8_BBASE
}
}

struct EpiStoreBf16 {
    static constexpr bool PERM = true;
    bf16_t* O; int ldc;
    DI void operator()(const f32x4 (&acc)[2][2][4][2], const pg8::Unit& u, int wr, int wc, int fr, int fq) const {
        const int row0 = u.pm * 256 + wr * 64 + fr, col0 = u.pn * 256 + wc * 32 + 8 * fq;
#pragma unroll
        for (int ai = 0; ai < 2; ++ai)
#pragma unroll
            for (int m = 0; m < 4; ++m) { bf16_t* rowp = O + (size_t)(row0 + ai * 128 + m * 16) * ldc + col0;
#pragma unroll
                for (int bj = 0; bj < 2; ++bj) { const f32x4 v0 = acc[ai][bj][m][0], v1 = acc[ai][bj][m][1];
                    u32x4 w; w.x = pk2(v0[0], v0[1]); w.y = pk2(v0[2], v0[3]); w.z = pk2(v1[0], v1[1]); w.w = pk2(v1[2], v1[3]);
                    *(u32x4*)(rowp + bj * 128) = w; } }
    }
};
struct EpiPool {
    static constexpr bool PERM = true;
    bf16_t* O; int ldc; const float* ps;
    DI void operator()(const f32x4 (&acc)[2][2][4][2], const pg8::Unit& u, int wr, int wc, int fr, int fq) const {
        const int row0 = u.pm * 256 + wr * 64 + fr, col0 = u.pn * 256 + wc * 32 + 8 * fq;
#pragma unroll
        for (int bj = 0; bj < 2; ++bj) {
            const f32x4 p0 = *(const f32x4*)(ps + col0 + bj * 128), p1 = *(const f32x4*)(ps + col0 + bj * 128 + 4);
#pragma unroll
            for (int ai = 0; ai < 2; ++ai)
#pragma unroll
                for (int m = 0; m < 4; ++m) { bf16_t* ptr = O + (size_t)(row0 + ai * 128 + m * 16) * ldc + col0 + bj * 128;
                    const u32x4 gr = *(const u32x4*)ptr; const f32x4 v0 = acc[ai][bj][m][0], v1 = acc[ai][bj][m][1];
                    u32x4 w;
                    w.x = pk2(v0[0] * p0[0] * silu(lo_bf(gr.x)), v0[1] * p0[1] * silu(hi_bf(gr.x)));
                    w.y = pk2(v0[2] * p0[2] * silu(lo_bf(gr.y)), v0[3] * p0[3] * silu(hi_bf(gr.y)));
                    w.z = pk2(v1[0] * p1[0] * silu(lo_bf(gr.z)), v1[1] * p1[1] * silu(hi_bf(gr.z)));
                    w.w = pk2(v1[2] * p1[2] * silu(lo_bf(gr.w)), v1[3] * p1[3] * silu(hi_bf(gr.w)));
                    *(u32x4*)ptr = w; }
        }
    }
};
struct EpiOut {
    static constexpr bool PERM = false;
    float* out; float* ctxv; const float* xin; const float* cin; const float* gt0; const float* stats; const float* lg; const float* lb; int mode; int row_base;
    DI void operator()(const f32x4 (&acc)[2][2][4][2], const pg8::Unit& u, int wr, int wc, int fr, int fq) const {
        const int rowt = row_base + u.pm * 256, col0 = u.pn * 256 + wc * 32 + 4 * fq, rl = wr * 64 + fr;
        const int cd = cond_of_row(rowt);
        const float* gtp = gt0 + (size_t)cd * 6144;
        float* dbase = rowt < TL ? out + (size_t)rowt * D : ctxv + (size_t)(rowt - TL) * D;
        const float* sbase = mode ? (const float*)dbase : (rowt < TL ? xin + (size_t)rowt * D : cin + (size_t)(rowt - TL) * D);
#pragma unroll
        for (int bj = 0; bj < 2; ++bj) {
            f32x4 gv[2], gg[2], bb[2], xv[2][8];
#pragma unroll
            for (int n = 0; n < 2; ++n) {
                const int c = col0 + bj * 128 + n * 16;
                gv[n] = *(const f32x4*)(gtp + c);
                gg[n] = (f32x4){1.f, 1.f, 1.f, 1.f}; bb[n] = (f32x4){0.f, 0.f, 0.f, 0.f};
                if (mode) { gg[n] = *(const f32x4*)(lg + c); bb[n] = *(const f32x4*)(lb + c); }
#pragma unroll
                for (int q = 0; q < 8; ++q) { const int rr = rl + (q >> 2) * 128 + (q & 3) * 16; xv[n][q] = *(const f32x4*)(sbase + (size_t)rr * D + c); }
            }
#pragma unroll
            for (int n = 0; n < 2; ++n) {
                const int c = col0 + bj * 128 + n * 16;
#pragma unroll
                for (int q = 0; q < 8; ++q) {
                    const int rr = rl + (q >> 2) * 128 + (q & 3) * 16;
                    f32x4 x = xv[n][q];
                    if (mode) { const float mu = stats[2 * (rowt + rr)], rs = stats[2 * (rowt + rr) + 1]; x = (x - mu) * rs * gg[n] + bb[n]; }
                    *(f32x4*)(dbase + (size_t)rr * D + c) = ALPHA * x + gv[n] * acc[q >> 2][bj][q & 3][n];
                }
            }
        }
    }
};

DI void phase_mod(const Params& p, unsigned char* lds) {
    float* s = (float*)lds;
    float* part = s + 3 * 2048;
    float* mod = (float*)(p.ws + WS_MOD);
    const int tid = threadIdx.x;
    for (int i = tid; i < 3 * 2048; i += 512) { const int cd = i >> 11, k = i & 2047; const float v = cd < 2 ? p.in[1][cd * 2048 + k] : p.in[3][k]; s[i] = silu(v); }
    __syncthreads();
    const int cgp = tid & 15, kr = tid >> 4;
    for (int item = blockIdx.x; item < 4 * 96; item += gridDim.x) {
        const int l = item / 96, nb = item % 96;
        const float* w = p.in[4] + (size_t)l * 2048 * 6144 + nb * 64 + cgp * 4;
        f32x4 a0 = {0.f, 0.f, 0.f, 0.f}, a1 = a0, a2 = a0;
#pragma unroll 8
        for (int i = 0; i < 64; ++i) { const int k = kr + 32 * i; const f32x4 wv = *(const f32x4*)(w + (size_t)k * 6144); a0 += wv * s[k]; a1 += wv * s[2048 + k]; a2 += wv * s[4096 + k]; }
        *(f32x4*)(part + (kr * 3 + 0) * 64 + cgp * 4) = a0;
        *(f32x4*)(part + (kr * 3 + 1) * 64 + cgp * 4) = a1;
        *(f32x4*)(part + (kr * 3 + 2) * 64 + cgp * 4) = a2;
        __syncthreads();
        if (tid < 192) { const int cd = tid >> 6, n = tid & 63; float acc = p.in[5][l * 6144 + nb * 64 + n];
            for (int q = 0; q < 32; ++q) acc += part[(q * 3 + cd) * 64 + n];
            mod[(size_t)(l * 3 + cd) * 6144 + nb * 64 + n] = acc; }
        __syncthreads();
    }
}

DI void conv_tile(const float* src, int ld_src, int src_col, int k0, bf16_t* dst, int ld_dst, int n0, unsigned char* lds) {
    bf16_t* t = (bf16_t*)lds;
    const int tid = threadIdx.x;
    const int col = tid & 31, kr = tid >> 5;
#pragma unroll 4
    for (int i = 0; i < 16; ++i) { const int k = kr + 16 * i; const float v = src_col >= 0 ? src[(size_t)(k0 + k) * ld_src + src_col + col] : 0.f; t[col * 264 + k] = f2bf(v); }
    __syncthreads();
    const int n = tid >> 4, ks = (tid & 15) * 16;
    const u32x4 a = *(const u32x4*)(t + n * 264 + ks), b = *(const u32x4*)(t + n * 264 + ks + 8);
    bf16_t* o = dst + (size_t)(n0 + n) * ld_dst + k0 + ks;
    *(u32x4*)o = a; *(u32x4*)(o + 8) = b;
    __syncthreads();
}
DI int even_src_col(int n) {
    if (n >= 8224) return -1;
    if (n >= 8192) return 2048 + (n - 8192);
    const int seg = n >> 10; const int d = seg < 2 ? 0 : ((seg == 2 || seg == 7) ? 32 : (seg == 6 ? -3040 : 1056));
    return n + d;
}
DI void phase_convert(const Params& p, int layer, unsigned char* lds, int parts, int bid, int nb) {
    const int j = layer >> 1;
    bf16_t* WIN = (bf16_t*)(p.ws + win_off(layer)); bf16_t* WPOOL = (bf16_t*)(p.ws + WS_WPOOL); bf16_t* WOUT = (bf16_t*)(p.ws + wout_off(layer));
    if ((layer & 1) == 0) {
        const int nA = (parts & 1) ? 264 * 8 : 0, nB = (parts & 2) ? 64 * 8 : 0;
        for (int idx = bid; idx < nA + nB; idx += nb) {
            if (idx < nA) { const int nbk = idx >> 3, kt = idx & 7; conv_tile(p.in[8] + (size_t)j * 2048 * 8224, 8224, even_src_col(32 * nbk), 256 * kt, WIN, 2048, 32 * nbk, lds); }
            else { const int i2 = idx - nA, nbk = i2 >> 3, kt = i2 & 7; conv_tile(p.in[15] + (size_t)j * 2048 * 2048, 2048, 32 * nbk, 256 * kt, WOUT, 2048, 32 * nbk, lds); }
        }
    } else {
        const int nA = (parts & 1) ? 64 * 8 : 0, nP = (parts & 1) ? 128 : 0, nB = (parts & 2) ? 64 * 8 : 0;
        for (int idx = bid; idx < nA + nP + nB; idx += nb) {
            if (idx < nA) { const int nbk = 64 + (idx >> 3), kt = idx & 7; conv_tile(p.in[16] + (size_t)j * 2048 * 4096, 4096, 32 * nbk, 256 * kt, WIN, 2048, 32 * nbk, lds); }
            else if (idx < nA + nP) { const int i2 = idx - nA, gq = i2 >> 5, nbk = (i2 >> 1) & 15, kt = i2 & 1;
                conv_tile(p.in[17] + (size_t)(j * 4 + gq) * 512 * 512, 512, 32 * nbk, 256 * kt, WPOOL, 512, gq * 512 + 32 * nbk, lds); }
            else { const int i2 = idx - nA - nP, nbk = i2 >> 3, kt = i2 & 7; conv_tile(p.in[19] + (size_t)j * 2048 * 2048, 2048, 32 * nbk, 256 * kt, WOUT, 2048, 32 * nbk, lds); }
        }
        if (parts & 1) {
            const float* srcw = p.in[16] + (size_t)j * 2048 * 4096; bf16_t* WB = (bf16_t*)(p.ws + WS_WINB);
            for (int e = (bid * 512 + (int)threadIdx.x) * 4; e < 2048 * 2048; e += nb * 512 * 4) {
                const int k = e >> 11, c = e & 2047; const f32x4 v = *(const f32x4*)(srcw + (size_t)k * 4096 + c);
                u32x2 w; w.x = pk2(v[0], v[1]); w.y = pk2(v[2], v[3]); *(u32x2*)(WB + e) = w; }
        }
    }
}

DI void phase_norm(const Params& p, int mode, int l, int row_lo, int nrows, int bid, int nb) {
    const int lane = threadIdx.x & 63, wave = threadIdx.x >> 6;
    const int gw = bid * 8 + wave, nw = nb * 8;
    const float* mod = (const float*)(p.ws + WS_MOD);
    float* stats = (float*)(p.ws + WS_STATS);
    bf16_t* U = (bf16_t*)(p.ws + WS_U);
    const int lnext = mode == 0 ? 0 : l + 1;
    f32x4 vn[8];
    if (row_lo + gw < nrows) { const int r0 = row_lo + gw; const float* src0 = mode == 0 ? xin_row(p, r0) : (const float*)vrow(p, r0);
#pragma unroll
        for (int i = 0; i < 8; ++i) vn[i] = *(const f32x4*)(src0 + i * 256 + lane * 4); }
    for (int r = row_lo + gw; r < nrows; r += nw) {
        f32x4 v[8];
#pragma unroll
        for (int i = 0; i < 8; ++i) v[i] = vn[i];
        { const int rn = r + nw < nrows ? r + nw : r;
          const float* srcn = mode == 0 ? xin_row(p, rn) : (const float*)vrow(p, rn);
#pragma unroll
          for (int i = 0; i < 8; ++i) vn[i] = *(const f32x4*)(srcn + i * 256 + lane * 4); }
        if (mode != 0) {
            float s = 0.f;
#pragma unroll
            for (int i = 0; i < 8; ++i) s += v[i][0] + v[i][1] + v[i][2] + v[i][3];
            s = wave_sum(s); const float mu = s * (1.f / 2048.f);
            float q = 0.f;
#pragma unroll
            for (int i = 0; i < 8; ++i) { const f32x4 d = v[i] - mu; q += d[0] * d[0] + d[1] * d[1] + d[2] * d[2] + d[3] * d[3]; }
            q = wave_sum(q); const float rs = rsqrtf(q * (1.f / 2048.f) + LN_EPS);
            if (mode == 1 && lane == 0) { stats[2 * r] = mu; stats[2 * r + 1] = rs; }
            const float* lg = p.in[6] + (size_t)l * D; const float* lb = p.in[7] + (size_t)l * D;
#pragma unroll
            for (int i = 0; i < 8; ++i) { const f32x4 gg = *(const f32x4*)(lg + i * 256 + lane * 4), bb = *(const f32x4*)(lb + i * 256 + lane * 4); v[i] = (v[i] - mu) * rs * gg + bb; }
        }
        if (mode == 2) {
            float* dst = p.out + (size_t)r * D;
#pragma unroll
            for (int i = 0; i < 8; ++i) *(f32x4*)(dst + i * 256 + lane * 4) = v[i];
        } else {
            const int cd = cond_of_row(r);
            const float* sh = mod + (size_t)(lnext * 3 + cd) * 6144; const float* sc = sh + 2048;
            bf16_t* dst = U + (size_t)r * D;
#pragma unroll
            for (int i = 0; i < 8; ++i) { const int c = i * 256 + lane * 4; const f32x4 a = *(const f32x4*)(sh + c), b = *(const f32x4*)(sc + c);
                const f32x4 o = v[i] * (1.f + b) + a; u32x2 w; w.x = pk2(o[0], o[1]); w.y = pk2(o[2], o[3]); *(u32x2*)(dst + c) = w; }
        }
    }
}

template <int DIR>
DI float prep_gate_loop(const float* r_s, bf16_t* qt, bf16_t* kt, const float (&w)[16], float bias, int kk) {
    constexpr float LOG2E = 1.4426950408889634f;
    float g = 0.f;
    for (int blk = 0; blk < 4; ++blk) {
        float la[16];
#pragma unroll
        for (int i = 0; i < 16; ++i) {
            const int tt = blk * 16 + i; const int t = DIR ? 63 - tt : tt;
            const f32x4* rr = (const f32x4*)(r_s + t * 32 + DIR * 16);
            const f32x4 r0 = rr[0], r1 = rr[1], r2 = rr[2], r3 = rr[3];
            float s0 = __builtin_fmaf(r0[0], w[0], bias), s1 = r0[1] * w[1], s2 = r0[2] * w[2], s3 = r0[3] * w[3];
            s0 = __builtin_fmaf(r1[0], w[4], s0); s1 = __builtin_fmaf(r1[1], w[5], s1); s2 = __builtin_fmaf(r1[2], w[6], s2); s3 = __builtin_fmaf(r1[3], w[7], s3);
            s0 = __builtin_fmaf(r2[0], w[8], s0); s1 = __builtin_fmaf(r2[1], w[9], s1); s2 = __builtin_fmaf(r2[2], w[10], s2); s3 = __builtin_fmaf(r2[3], w[11], s3);
            s0 = __builtin_fmaf(r3[0], w[12], s0); s1 = __builtin_fmaf(r3[1], w[13], s1); s2 = __builtin_fmaf(r3[2], w[14], s2); s3 = __builtin_fmaf(r3[3], w[15], s3);
            const float pre = (s0 + s1) + (s2 + s3);
            const float ex = __builtin_amdgcn_exp2f(-fabsf(pre) * LOG2E);
            la[i] = (fminf(pre, 0.f) * LOG2E - __builtin_amdgcn_logf(1.f + ex)) * 0.0625f;
        }
#pragma unroll
        for (int i = 0; i < 16; ++i) { g += la[i]; la[i] = g; }
#pragma unroll
        for (int i = 0; i < 16; ++i) {
            const int tt = blk * 16 + i; const int t = DIR ? 63 - tt : tt;
            const float e = __builtin_amdgcn_exp2f(la[i]);
            bf16_t* qp = qt + (DIR * 64 + t) * 264 + kk; bf16_t* kp = kt + (DIR * 64 + t) * 264 + kk;
            const float qv = bf2f(*qp), kv = bf2f(*kp);
            *qp = f2bf(qv * 0.0625f * e);
            *kp = f2bf(kv * __builtin_amdgcn_rcpf(e));
        }
    }
    return __builtin_amdgcn_exp2f(g);
}

struct PrepIn { u32x4 q[4], k[4], v[4]; u32x2 rr; float w[16]; float bias; };
DI void prep_load(PrepIn& I, const Params& p, int j, int item, int tid) {
    const bf16_t* H = (const bf16_t*)(p.ws + WS_H);
    const int c = item >> 2, h = item & 3; const size_t row0 = (size_t)c * 64;
    const int dir = tid >> 8, kk = tid & 255;
    { const int t = tid >> 3, sg = tid & 7; I.rr = *(const u32x2*)(H + (row0 + t) * HE + 8192 + sg * 4); }
    const float* wgf = p.in[9]; const float* wgb = p.in[11]; const float* bgf = p.in[10]; const float* bgb = p.in[12];
    const float* wg = (dir ? wgb : wgf) + (size_t)j * 16 * 1024 + h * 256 + kk;
#pragma unroll
    for (int i = 0; i < 16; ++i) I.w[i] = wg[i * 1024];
    I.bias = (dir ? bgb : bgf)[j * 1024 + h * 256 + kk];
#pragma unroll
    for (int it = 0; it < 4; ++it) { const int idx = it * 512 + tid; const int t = idx >> 5, seg = idx & 31;
        I.q[it] = *(const u32x4*)(H + (row0 + t) * HE + 2048 + h * 256 + seg * 8);
        I.k[it] = *(const u32x4*)(H + (row0 + t) * HE + h * 256 + seg * 8);
        I.v[it] = *(const u32x4*)(H + (row0 + t) * HE + 1024 + h * 256 + seg * 8); }
}
DI void phase_prep(const Params& p, int j, unsigned char* lds) {
    float* r_s = (float*)lds;
    bf16_t* qt = (bf16_t*)(lds + 8192);
    bf16_t* kt = qt + 2 * 64 * 264;
    const bf16_t* H = (const bf16_t*)(p.ws + WS_H);
    const int tid = threadIdx.x, lane = tid & 63, wave = tid >> 6;
    const int dir = tid >> 8, kk = tid & 255;
    PrepIn I;
    if ((int)blockIdx.x < NCH * 4) prep_load(I, p, j, blockIdx.x, tid);
    for (int item = blockIdx.x; item < NCH * 4; item += gridDim.x) {
        {
            const int t = tid >> 3, sg = tid & 7;
            f32x4 o = {lo_bf(I.rr.x), hi_bf(I.rr.x), lo_bf(I.rr.y), hi_bf(I.rr.y)}; *(f32x4*)(r_s + t * 32 + sg * 4) = o;
#pragma unroll
            for (int it = 0; it < 4; ++it) { const int idx = it * 512 + tid; const int tq = idx >> 5, seg = idx & 31;
                *(u32x4*)(qt + tq * 264 + seg * 8) = I.q[it]; *(u32x4*)(qt + (64 + tq) * 264 + seg * 8) = I.q[it];
                *(u32x4*)(kt + tq * 264 + seg * 8) = I.k[it]; *(u32x4*)(kt + (64 + tq) * 264 + seg * 8) = I.k[it]; }
        }
        float w[16];
#pragma unroll
        for (int i = 0; i < 16; ++i) w[i] = I.w[i];
        const float bias = I.bias;
        u32x4 vcur[4];
#pragma unroll
        for (int it = 0; it < 4; ++it) vcur[it] = I.v[it];
        __syncthreads();
        float dlast;
        if (dir == 0) dlast = prep_gate_loop<0>(r_s, qt, kt, w, bias, kk); else dlast = prep_gate_loop<1>(r_s, qt, kt, w, bias, kk);
        ((float*)(p.ws + WS_DD))[(size_t)(item * 2 + dir) * 256 + kk] = dlast;
        { const int nitem = item + (int)gridDim.x; prep_load(I, p, j, nitem < NCH * 4 ? nitem : item, tid); }
        {
            bf16_t* KHp = (bf16_t*)(p.ws + WS_KH) + (size_t)(item * 2 + dir) * 16384;
            const int w8 = kk >> 5, r = kk & 31;
#pragma unroll
            for (int tg = 0; tg < 8; ++tg) {
                float val[8];
#pragma unroll
                for (int i = 0; i < 8; ++i) val[i] = bf2f(kt[(dir * 64 + 8 * tg + i) * 264 + kk]) * dlast;
                u32x4 pk; pk.x = pk2(val[0], val[1]); pk.y = pk2(val[2], val[3]); pk.z = pk2(val[4], val[5]); pk.w = pk2(val[6], val[7]);
                const int s = tg >> 1, hh = tg & 1;
                *(u32x4*)(KHp + ((w8 * 4 + s) * 64 + hh * 32 + r) * 8) = pk;
            }
        }
        __syncthreads();
        {
            bf16_t* QTp = (bf16_t*)(p.ws + WS_U) + (size_t)(item * 2) * 16384;
#pragma unroll
            for (int it = 0; it < 8; ++it) {
                const int idx = it * 512 + tid; const int d2 = idx >> 11, f = (idx >> 6) & 31, ln = idx & 63;
                const int w8 = f >> 2, mb = (f >> 1) & 1, s = f & 1, rr = ln & 31, hh = ln >> 5;
                const bf16_t* sp = qt + (d2 * 64 + 32 * mb + rr) * 264 + 32 * w8 + 16 * s + 4 * hh;
                const u32x2 lo = *(const u32x2*)sp, hi = *(const u32x2*)(sp + 8);
                u32x4 o; o.x = lo.x; o.y = lo.y; o.z = hi.x; o.w = hi.y;
                *(u32x4*)(QTp + (size_t)d2 * 16384 + (f * 64 + ln) * 8) = o;
            }
        }
        float amask[4][4];
        {
            const int d2 = wave >> 2, wd = wave & 3, fr = lane & 15, fq = lane >> 4;
            f32x4 acc[4];
#pragma unroll
            for (int nb = 0; nb < 4; ++nb) acc[nb] = (f32x4){0.f, 0.f, 0.f, 0.f};
            const bf16_t* qb = qt + (d2 * 64 + 16 * wd + fr) * 264 + 8 * fq;
            const bf16_t* kb = kt + (d2 * 64 + fr) * 264 + 8 * fq;
#pragma unroll
            for (int ks = 0; ks < 8; ++ks) {
                const bf16x8 a = *(const bf16x8*)(qb + 32 * ks);
#pragma unroll
                for (int nb = 0; nb < 4; ++nb) { const bf16x8 b = *(const bf16x8*)(kb + nb * 16 * 264 + 32 * ks); acc[nb] = __builtin_amdgcn_mfma_f32_16x16x32_bf16(a, b, acc[nb], 0, 0, 0); }
            }
#pragma unroll
            for (int nb = 0; nb < 4; ++nb)
#pragma unroll
                for (int jx = 0; jx < 4; ++jx) {
                    const int i = 16 * wd + 4 * fq + jx, jt = 16 * nb + fr;
                    const bool keep = d2 ? (jt >= i) : (jt <= i);
                    amask[nb][jx] = keep ? acc[nb][jx] : 0.f;
                }
        }
        __syncthreads();
        {
#pragma unroll
            for (int it = 0; it < 4; ++it) { const int idx = it * 512 + tid; const int t = idx >> 5, seg = idx & 31; *(u32x4*)(qt + t * 264 + seg * 8) = vcur[it]; }
        }
        {
            const int d2 = wave >> 2, wd = wave & 3, fr = lane & 15, fq = lane >> 4;
#pragma unroll
            for (int nb = 0; nb < 4; ++nb)
#pragma unroll
                for (int jx = 0; jx < 4; ++jx) {
                    const int i = 16 * wd + 4 * fq + jx, jt = 16 * nb + fr;
                    const int mb = i >> 5, r = i & 31, hh = (jt >> 3) & 1, jj = jt & 7;
                    kt[d2 * 4096 + ((nb * 2 + mb) * 64 + hh * 32 + r) * 8 + jj] = f2bf(amask[nb][jx]);
                }
        }
        __syncthreads();
        {
            bf16_t* AMp = (bf16_t*)(p.ws + WS_AM) + (size_t)(item * 2) * 4096;
            *(u32x4*)(AMp + tid * 8) = *(const u32x4*)(kt + tid * 8);
            *(u32x4*)(AMp + 4096 + tid * 8) = *(const u32x4*)(kt + 4096 + tid * 8);
        }
        {
            bf16_t* VTp = (bf16_t*)(p.ws + WS_VT) + (size_t)item * 16384;
#pragma unroll
            for (int it = 0; it < 4; ++it) {
                const int idx = it * 512 + tid; const int f = idx >> 6, ln = idx & 63; const int sl = f >> 2, s = f & 3, rr = ln & 31, hh = ln >> 5;
                const bf16_t* sp = qt + (16 * s + 8 * hh) * 264 + 32 * sl + rr;
                unsigned e[8];
#pragma unroll
                for (int jj = 0; jj < 8; ++jj) e[jj] = sp[jj * 264];
                u32x4 o; o.x = e[0] | (e[1] << 16); o.y = e[2] | (e[3] << 16); o.z = e[4] | (e[5] << 16); o.w = e[6] | (e[7] << 16);
                *(u32x4*)(VTp + (f * 64 + ln) * 8) = o;
            }
        }
        __syncthreads();
    }
}

DI void mix_conv(const Params& p, int j, int nrows, int gw, int nw);
DI int scan_chunk(int n, int b, int dir) {
    if (n < 4) return 512 + 4 * b + (dir ? 3 - n : n);
    const int m = n - 4; return 256 * b + (dir ? 255 - m : m);
}
struct ScanFrags { bf16x8 qa[2][2], ka[4], aa[2]; u32x4 stage; };
DI void scan_load(ScanFrags& F, const unsigned char* ws, int c, int h, int dir, int sl, int w, int lane) {
    const size_t blk = (size_t)((c * 4 + h) * 2 + dir);
    const bf16_t* QT = (const bf16_t*)(ws + WS_U) + blk * 16384 + lane * 8;
    const bf16_t* KH = (const bf16_t*)(ws + WS_KH) + blk * 16384 + lane * 8;
    const bf16_t* AM = (const bf16_t*)(ws + WS_AM) + blk * 4096 + lane * 8;
#pragma unroll
    for (int mb = 0; mb < 2; ++mb)
#pragma unroll
        for (int s = 0; s < 2; ++s) F.qa[mb][s] = *(const bf16x8*)(QT + ((w * 2 + mb) * 2 + s) * 512);
#pragma unroll
    for (int s = 0; s < 4; ++s) F.ka[s] = *(const bf16x8*)(KH + (w * 4 + s) * 512);
#pragma unroll
    for (int mb = 0; mb < 2; ++mb) F.aa[mb] = w < 4 ? *(const bf16x8*)(AM + ((w * 2 + mb)) * 512) : (bf16x8){0, 0, 0, 0, 0, 0, 0, 0};
    const int tid = w * 64 + lane;
    if (tid < 256) F.stage = *(const u32x4*)((const bf16_t*)(ws + WS_VT) + (size_t)(c * 4 + h) * 16384 + sl * 2048 + tid * 8);
    else if (tid < 320) F.stage = *(const u32x4*)((const float*)(ws + WS_DD) + blk * 256 + (tid - 256) * 4);
}
constexpr int SCAN_VB_OFF = 73728, SCAN_DD_OFF = 73728 + 8192;
DI void scan_stage_store(const ScanFrags& F, LAS unsigned char* lds, int buf, int tid) {
    if (tid < 256) *(LAS u32x4*)(lds + SCAN_VB_OFF + buf * 4096 + tid * 16) = F.stage;
    else if (tid < 320) *(LAS u32x4*)(lds + SCAN_DD_OFF + buf * 1024 + (tid - 256) * 16) = F.stage;
}
DI bf16x8 pack8(const f32x16& x, int s) {
    u32x4 pk; pk.x = pk2(x[8 * s], x[8 * s + 1]); pk.y = pk2(x[8 * s + 2], x[8 * s + 3]); pk.z = pk2(x[8 * s + 4], x[8 * s + 5]); pk.w = pk2(x[8 * s + 6], x[8 * s + 7]);
    return __builtin_bit_cast(bf16x8, pk);
}
DI void phase_scan(const Params& p, LAS unsigned char* lds, unsigned char* ldsg, int j, int conv_rows, int next_layer) {
    bf16_t* H = (bf16_t*)(p.ws + WS_H);
    const int tid = threadIdx.x, lane = tid & 63, w = tid >> 6, r = lane & 31, hh = lane >> 5;
    if (blockIdx.x >= 128) {
        const int nbk = (int)gridDim.x - 128, bid = (int)blockIdx.x - 128;
        mix_conv(p, j, conv_rows, bid * 8 + (tid >> 6), nbk * 8);
        phase_convert(p, next_layer, ldsg, 3, bid, nbk);
        if (next_layer == 1) phase_convert(p, 2, ldsg, 3, bid, nbk);
        mini_barrier((unsigned*)(p.ws + WS_BAR) + 3520 + 64 * j, (unsigned)nbk);
        {
            pg8::Gemm g{(const bf16_t*)(p.ws + WS_WPOOL), (const bf16_t*)(p.ws + WS_WINB), 2048, 2048, 512, 512, 0, 2048, 1};
            pg8::StaticOrder S; S.init(g.M, g.N, nbk, bid);
            EpiStoreBf16 E{(bf16_t*)(p.ws + WS_WIN), 2048};
            pg8::gemm_phase(lds, g, S, E);
        }
        return;
    }
    for (int id = blockIdx.x; id < 128; id += gridDim.x) {
        const int xcd = id & 7, widx = id >> 3; const int scan = xcd * 2 + (widx >> 3), sl = widx & 7;
        const int b = scan >> 3, h = (scan >> 1) & 3, dir = scan & 1;
        f32x16 S;
#pragma unroll
        for (int i = 0; i < 16; ++i) S[i] = 0.f;
        ScanFrags cur, nxt, nn;
        scan_load(cur, p.ws, scan_chunk(0, b, dir), h, dir, sl, w, lane);
        scan_load(nxt, p.ws, scan_chunk(1, b, dir), h, dir, sl, w, lane);
        scan_stage_store(cur, lds, 0, tid);
        __syncthreads();
        for (int n = 0; n < 260; ++n) {
            const int c = scan_chunk(n, b, dir);
            scan_load(nn, p.ws, scan_chunk(n < 258 ? n + 2 : 259, b, dir), h, dir, sl, w, lane);
            const bf16x8 sb0 = pack8(S, 0), sb1 = pack8(S, 1);
            bf16x8 vb[4]; f32x4 dd[4];
            {
                unsigned vo = (unsigned)(SCAN_VB_OFF + (n & 1) * 4096 + lane * 16), dofs = (unsigned)(SCAN_DD_OFF + (n & 1) * 1024 + (32 * w + 4 * hh) * 4);
                asm volatile("" : "+v"(vo), "+v"(dofs));
#pragma unroll
                for (int s = 0; s < 4; ++s) { vb[s] = *(const LAS bf16x8*)(lds + vo + s * 1024); dd[s] = *(const LAS f32x4*)(lds + dofs + s * 32); }
            }
            const bf16x8 vw = (w & 3) == 0 ? vb[0] : ((w & 3) == 1 ? vb[1] : ((w & 3) == 2 ? vb[2] : vb[3]));
            bf16x8 aa0 = cur.aa[0], aa1 = cur.aa[1];
            unsigned rbo = (unsigned)(((n & 1) * 8 + w) * 4608 + r * 72 + hh * 8);
            asm volatile("" : "+v"(rbo));
            LAS unsigned char* rb = lds + rbo;
#pragma unroll
            for (int mb = 0; mb < 2; ++mb) {
                f32x16 o;
#pragma unroll
                for (int i = 0; i < 16; ++i) o[i] = 0.f;
                o = __builtin_amdgcn_mfma_f32_32x32x16_bf16(sb0, cur.qa[mb][0], o, 0, 0, 0);
                o = __builtin_amdgcn_mfma_f32_32x32x16_bf16(sb1, cur.qa[mb][1], o, 0, 0, 0);
                o = __builtin_amdgcn_mfma_f32_32x32x16_bf16(vw, mb ? aa1 : aa0, o, 0, 0, 0);
#pragma unroll
                for (int g = 0; g < 4; ++g) { u32x2 pk; pk.x = pk2(o[4 * g], o[4 * g + 1]); pk.y = pk2(o[4 * g + 2], o[4 * g + 3]);
                    *(LAS u32x2*)(rb + mb * 2304 + g * 16) = pk; }
            }
#pragma unroll
            for (int i = 0; i < 16; ++i) S[i] *= dd[i >> 2][i & 3];
#pragma unroll
            for (int s = 0; s < 4; ++s) S = __builtin_amdgcn_mfma_f32_32x32x16_bf16(cur.ka[s], vb[s], S, 0, 0, 0);
            scan_stage_store(nxt, lds, (n + 1) & 1, tid);
            __syncthreads();
            {
                const int i = tid >> 3, vq = (tid & 7) * 4;
                unsigned rpo = (unsigned)((n & 1) * 8 * 4608 + i * 72 + vq * 2);
                asm volatile("" : "+v"(rpo));
                const LAS unsigned char* rp = lds + rpo;
                float a0 = 0.f, a1 = 0.f, a2 = 0.f, a3 = 0.f;
#pragma unroll
                for (int ww = 0; ww < 8; ++ww) { const u32x2 q = *(const LAS u32x2*)(rp + ww * 4608); a0 += lo_bf(q.x); a1 += hi_bf(q.x); a2 += lo_bf(q.y); a3 += hi_bf(q.y); }
                u32x2 ov; ov.x = pk2(a0, a1); ov.y = pk2(a2, a3);
                *(u32x2*)(H + (size_t)(64 * c + i) * HE + (dir ? 2048 : 0) + h * 256 + 32 * sl + vq) = ov;
            }
            cur = nxt; nxt = nn;
        }
        __syncthreads();
    }
}

DI void phase_mix_gla(const Params& p, int j, int row_lo, int nrows, int bid, int nb) {
    bf16_t* H = (bf16_t*)(p.ws + WS_H);
    const int lane = threadIdx.x & 63, wave = threadIdx.x >> 6;
    const int gw = bid * 8 + wave, nw = nb * 8;
    const float* gnw = p.in[13] + (size_t)j * 256;
    for (int r = row_lo + gw; r < nrows; r += nw) {
        bf16_t* row = H + (size_t)r * HE;
        {
            const int c0 = lane * 16;
            float o[16];
            const u32x4 gq0 = *(const u32x4*)(row + 6144 + c0), gq1 = *(const u32x4*)(row + 6144 + c0 + 8);
#pragma unroll
            for (int q = 0; q < 2; ++q) { const u32x4 a = *(const u32x4*)(row + c0 + 8 * q), b = *(const u32x4*)(row + 2048 + c0 + 8 * q);
                o[8 * q + 0] = lo_bf(a.x) + lo_bf(b.x); o[8 * q + 1] = hi_bf(a.x) + hi_bf(b.x); o[8 * q + 2] = lo_bf(a.y) + lo_bf(b.y); o[8 * q + 3] = hi_bf(a.y) + hi_bf(b.y);
                o[8 * q + 4] = lo_bf(a.z) + lo_bf(b.z); o[8 * q + 5] = hi_bf(a.z) + hi_bf(b.z); o[8 * q + 6] = lo_bf(a.w) + lo_bf(b.w); o[8 * q + 7] = hi_bf(a.w) + hi_bf(b.w); }
            float ss = 0.f;
#pragma unroll
            for (int i = 0; i < 16; ++i) ss += o[i] * o[i];
#pragma unroll
            for (int m = 8; m > 0; m >>= 1) ss += __shfl_xor(ss, m);
            const float rs = rsqrtf(ss * (1.f / 256.f) + LN_EPS);
            const int vc = (lane & 15) * 16;
#pragma unroll
            for (int q = 0; q < 2; ++q) { const u32x4 gq = q ? gq1 : gq0;
                const f32x4 w0 = *(const f32x4*)(gnw + vc + 8 * q), w1 = *(const f32x4*)(gnw + vc + 8 * q + 4);
                u32x4 y;
                y.x = pk2(o[8 * q + 0] * rs * w0[0] * silu(lo_bf(gq.x)), o[8 * q + 1] * rs * w0[1] * silu(hi_bf(gq.x)));
                y.y = pk2(o[8 * q + 2] * rs * w0[2] * silu(lo_bf(gq.y)), o[8 * q + 3] * rs * w0[3] * silu(hi_bf(gq.y)));
                y.z = pk2(o[8 * q + 4] * rs * w1[0] * silu(lo_bf(gq.z)), o[8 * q + 5] * rs * w1[1] * silu(hi_bf(gq.z)));
                y.w = pk2(o[8 * q + 6] * rs * w1[2] * silu(lo_bf(gq.w)), o[8 * q + 7] * rs * w1[3] * silu(hi_bf(gq.w)));
                *(u32x4*)(row + 6144 + c0 + 8 * q) = y; }
        }
    }
}
DI void mix_conv(const Params& p, int j, int nrows, int gw, int nw) {
    bf16_t* H = (bf16_t*)(p.ws + WS_H);
    const int lane = threadIdx.x & 63;
    const float* cw = p.in[14] + (size_t)j * 3 * 1024;
    for (int r = gw; r < nrows; r += nw) {
        bf16_t* row = H + (size_t)r * HE;
        {
            const int c0 = lane * 16;
            const bool hasp = r < TL ? ((r & 63) != 0) : ((r & 255) != 0);
            const bool hasn = r < TL ? ((r & 63) != 63) : ((r & 255) != 255);
#pragma unroll
            for (int q = 0; q < 2; ++q) {
                const int cc = c0 + 8 * q;
                float u0[8], u1[8], u2[8];
                { const u32x4 a = *(const u32x4*)(row + 4096 + cc), b = *(const u32x4*)(row + 5120 + cc);
                  u1[0] = lo_bf(a.x) * lo_bf(b.x); u1[1] = hi_bf(a.x) * hi_bf(b.x); u1[2] = lo_bf(a.y) * lo_bf(b.y); u1[3] = hi_bf(a.y) * hi_bf(b.y);
                  u1[4] = lo_bf(a.z) * lo_bf(b.z); u1[5] = hi_bf(a.z) * hi_bf(b.z); u1[6] = lo_bf(a.w) * lo_bf(b.w); u1[7] = hi_bf(a.w) * hi_bf(b.w); }
                if (hasp) { const u32x4 a = *(const u32x4*)(row - HE + 4096 + cc), b = *(const u32x4*)(row - HE + 5120 + cc);
                  u0[0] = lo_bf(a.x) * lo_bf(b.x); u0[1] = hi_bf(a.x) * hi_bf(b.x); u0[2] = lo_bf(a.y) * lo_bf(b.y); u0[3] = hi_bf(a.y) * hi_bf(b.y);
                  u0[4] = lo_bf(a.z) * lo_bf(b.z); u0[5] = hi_bf(a.z) * hi_bf(b.z); u0[6] = lo_bf(a.w) * lo_bf(b.w); u0[7] = hi_bf(a.w) * hi_bf(b.w); }
                else {
#pragma unroll
                    for (int i = 0; i < 8; ++i) u0[i] = 0.f; }
                if (hasn) { const u32x4 a = *(const u32x4*)(row + HE + 4096 + cc), b = *(const u32x4*)(row + HE + 5120 + cc);
                  u2[0] = lo_bf(a.x) * lo_bf(b.x); u2[1] = hi_bf(a.x) * hi_bf(b.x); u2[2] = lo_bf(a.y) * lo_bf(b.y); u2[3] = hi_bf(a.y) * hi_bf(b.y);
                  u2[4] = lo_bf(a.z) * lo_bf(b.z); u2[5] = hi_bf(a.z) * hi_bf(b.z); u2[6] = lo_bf(a.w) * lo_bf(b.w); u2[7] = hi_bf(a.w) * hi_bf(b.w); }
                else {
#pragma unroll
                    for (int i = 0; i < 8; ++i) u2[i] = 0.f; }
                const u32x4 ab = *(const u32x4*)(row + 3072 + cc), ga = *(const u32x4*)(row + 7168 + cc);
                float abf[8] = {lo_bf(ab.x), hi_bf(ab.x), lo_bf(ab.y), hi_bf(ab.y), lo_bf(ab.z), hi_bf(ab.z), lo_bf(ab.w), hi_bf(ab.w)};
                float gaf[8] = {lo_bf(ga.x), hi_bf(ga.x), lo_bf(ga.y), hi_bf(ga.y), lo_bf(ga.z), hi_bf(ga.z), lo_bf(ga.w), hi_bf(ga.w)};
                float y[8];
#pragma unroll
                for (int hq = 0; hq < 2; ++hq) {
                    const f32x4 w0 = *(const f32x4*)(cw + cc + 4 * hq), w1 = *(const f32x4*)(cw + 1024 + cc + 4 * hq), w2 = *(const f32x4*)(cw + 2048 + cc + 4 * hq);
#pragma unroll
                    for (int i = 0; i < 4; ++i) { const int e = 4 * hq + i; y[e] = abf[e] * (w0[i] * u0[e] + w1[i] * u1[e] + w2[i] * u2[e]) * silu(gaf[e]); }
                }
                u32x4 yo; yo.x = pk2(y[0], y[1]); yo.y = pk2(y[2], y[3]); yo.z = pk2(y[4], y[5]); yo.w = pk2(y[6], y[7]);
                *(u32x4*)(row + 7168 + cc) = yo;
            }
        }
    }
}

template <int WIN>
DI void pool_item(bf16_t* H, const float* ps, int r, int gq, int lane) {
    int pos, stride, base;
    if (r < TL) { const int t = r & 16383; pos = t >> 6; stride = 64; base = r - pos * 64; }
    else { const int t = (r - TL) & 255; pos = t; stride = 1; base = r - pos; }
    const int col = gq * 512 + lane * 8;
    u32x4 v[WIN];
#pragma unroll
    for (int i = 0; i < WIN; ++i) { int q = pos - WIN / 2 + i; q = q < 0 ? 0 : (q > 255 ? 255 : q); v[i] = *(const u32x4*)(H + (size_t)(base + q * stride) * HO + col); }
    bf16_t* gp = H + (size_t)r * HO + 2048 + col;
    const u32x4 gt = *(const u32x4*)gp;
    const f32x4 p0 = *(const f32x4*)(ps + col), p1 = *(const f32x4*)(ps + col + 4);
    float acc[8];
#pragma unroll
    for (int i = 0; i < 8; ++i) acc[i] = 0.f;
#pragma unroll
    for (int i = 0; i < WIN; ++i) { const int q = pos - WIN / 2 + i; const float m = (q >= 0 && q < 256) ? 1.f : 0.f;
        acc[0] += m * lo_bf(v[i].x); acc[1] += m * hi_bf(v[i].x); acc[2] += m * lo_bf(v[i].y); acc[3] += m * hi_bf(v[i].y);
        acc[4] += m * lo_bf(v[i].z); acc[5] += m * hi_bf(v[i].z); acc[6] += m * lo_bf(v[i].w); acc[7] += m * hi_bf(v[i].w); }
    int lo = pos - WIN / 2, hi = pos + WIN - WIN / 2; lo = lo < 0 ? 0 : lo; hi = hi > 256 ? 256 : hi;
    const float inv = 1.f / (float)(hi - lo);
    const u32x4 s = v[WIN / 2];
    u32x4 o;
    o.x = pk2((acc[0] * inv - lo_bf(s.x)) * p0[0] * silu(lo_bf(gt.x)), (acc[1] * inv - hi_bf(s.x)) * p0[1] * silu(hi_bf(gt.x)));
    o.y = pk2((acc[2] * inv - lo_bf(s.y)) * p0[2] * silu(lo_bf(gt.y)), (acc[3] * inv - hi_bf(s.y)) * p0[3] * silu(hi_bf(gt.y)));
    o.z = pk2((acc[4] * inv - lo_bf(s.z)) * p1[0] * silu(lo_bf(gt.z)), (acc[5] * inv - hi_bf(s.z)) * p1[1] * silu(hi_bf(gt.z)));
    o.w = pk2((acc[6] * inv - lo_bf(s.w)) * p1[2] * silu(lo_bf(gt.w)), (acc[7] * inv - hi_bf(s.w)) * p1[3] * silu(hi_bf(gt.w)));
    *(u32x4*)gp = o;
}
DI void phase_poolmix(const Params& p, int j, int row_lo, int nrows, int bid, int nb) {
    bf16_t* H = (bf16_t*)(p.ws + WS_H);
    const float* Z = p.in[18] + (size_t)j * D;
    const int lane = threadIdx.x & 63, wave = threadIdx.x >> 6;
    const int gw = bid * 8 + wave, nw = nb * 8;
    for (int it = row_lo * 4 + gw; it < nrows * 4; it += nw) {
        const int r = it >> 2, gq = it & 3;
        if (gq == 0) pool_item<2>(H, Z, r, gq, lane);
        else if (gq == 1) pool_item<4>(H, Z, r, gq, lane);
        else if (gq == 2) pool_item<8>(H, Z, r, gq, lane);
        else pool_item<16>(H, Z, r, gq, lane);
    }
}


#define XB_TMO      128
#define XB_XCNT(j)  (256  + 64 * (j))
#define XB_XSUB(j)  (1280 + 64 * (j))
#define XB_XGEN(j)  (2304 + 64 * (j))
#define XB_TOP      3328
#define XB_TOPGEN   3392
#define XCD_BAR_WORDS 3456
#define XB_SPIN_CAP (1u << 18)
DI unsigned xb_xcc_id() { return (unsigned)__builtin_amdgcn_s_getreg((3 << 11) | 20) & 0xFu; }
#define XB_SPIN(cond, bar) do { unsigned _sp = 0; while (cond) { __builtin_amdgcn_s_sleep(1); \
    if ((++_sp & 255u) == 0u) { if (xb_ld(&(bar)[XB_TMO])) break; if (_sp > XB_SPIN_CAP) { atomicAdd(&(bar)[XB_TMO], 1u); break; } } } } while (0)
struct XcdBarrier { unsigned* bar; unsigned x; volatile LAS unsigned* st; };
DI XcdBarrier xcd_barrier_post(unsigned* bar, volatile LAS unsigned* st) {
    XcdBarrier b; b.bar = bar; b.x = xb_xcc_id(); b.st = st;
    if (threadIdx.x == 0) (void)xb_add(&bar[XB_XCNT(b.x)], 1u);
    return b;
}
DI void xcd_barrier_complete(unsigned* bar, unsigned x, unsigned& nloc, unsigned& nx) {
    const unsigned G = gridDim.x * gridDim.y * gridDim.z;
    unsigned sum, cnt, mine, sp = 0u;
    for (;;) {
        sum = 0u; cnt = 0u; mine = 0u;
#pragma unroll
        for (unsigned j = 0; j < 16; ++j) { const unsigned c = xb_ld(&bar[XB_XCNT(j)]); sum += c; cnt += (c > 0u) ? 1u : 0u; mine = (j == x) ? c : mine; }
        if (sum == G) break;
        __builtin_amdgcn_s_sleep(1);
        if ((++sp & 255u) == 0u) { if (xb_ld(&bar[XB_TMO])) break; if (sp > XB_SPIN_CAP) { atomicAdd(&bar[XB_TMO], 1u); break; } }
    }
    nloc = mine > 0u ? mine : 1u; nx = cnt > 0u ? cnt : 1u;
}
DI void xcd_barrier(const XcdBarrier& b) {
    asm volatile("s_waitcnt vmcnt(0)" ::: "memory");
    __syncthreads();
    if (threadIdx.x == 0) {
        unsigned* bar = b.bar;
        __builtin_amdgcn_s_waitcnt(0);
        unsigned nloc = b.st[0], nx = b.st[1];
        if (nloc == 0u) { xcd_barrier_complete(bar, b.x, nloc, nx); b.st[0] = nloc; b.st[1] = nx; }
        const unsigned old = xb_add(&bar[XB_XSUB(b.x)], 1u);
        const unsigned gen = old / nloc;
        if (old + 1u == (gen + 1u) * nloc) {
            __builtin_amdgcn_fence(__ATOMIC_RELEASE, "agent");
            asm volatile("s_waitcnt vmcnt(0)" ::: "memory");
            const unsigned og = xb_add(&bar[XB_TOP], 1u);
            const unsigned tg = og / nx;
            if (og + 1u == (tg + 1u) * nx) xb_add(&bar[XB_TOPGEN], 1u);
            else XB_SPIN(xb_ld(&bar[XB_TOPGEN]) == tg, bar);
            __builtin_amdgcn_fence(__ATOMIC_ACQUIRE, "agent");
            xb_add(&bar[XB_XGEN(b.x)], 1u);
            asm volatile("s_waitcnt vmcnt(0)" ::: "memory");
        } else {
            XB_SPIN(xb_ld(&bar[XB_XGEN(b.x)]) == gen, bar);
            __builtin_amdgcn_fence(__ATOMIC_ACQUIRE, "agent");
            asm volatile("s_waitcnt vmcnt(0)" ::: "memory");
        }
    }
    __syncthreads();
}

DI void gemm_in_even(const Params& p, int layer, LAS unsigned char* lds) {
    pg8::Gemm g{(const bf16_t*)(p.ws + WS_U), (const bf16_t*)(p.ws + win_off(layer)), R, HE, D, D, 0, D, 0};
    pg8::StaticOrder S; S.init(g.M, g.N, (int)gridDim.x, (int)blockIdx.x);
    EpiStoreBf16 E{(bf16_t*)(p.ws + WS_H), HE};
    pg8::gemm_phase(lds, g, S, E);
}
DI void gemm_in_odd(const Params& p, int M, LAS unsigned char* lds) {
    pg8::Gemm g{(const bf16_t*)(p.ws + WS_U), (const bf16_t*)(p.ws + WS_WIN), M, HO, D, D, 0, D, 0};
    pg8::StaticOrder S; S.init(g.M, g.N, (int)gridDim.x, (int)blockIdx.x);
    EpiStoreBf16 E{(bf16_t*)(p.ws + WS_H), HO};
    pg8::gemm_phase(lds, g, S, E);
}
DI void gemm_out(const Params& p, int layer, int row_base, int M, int bid, int nb, LAS unsigned char* lds) {
    const bool even = (layer & 1) == 0;
    const int ldh = even ? HE : HO;
    pg8::Gemm g{(const bf16_t*)(p.ws + WS_H) + (size_t)row_base * ldh + (even ? 6144 : 2048), (const bf16_t*)(p.ws + wout_off(layer)), M, D, D, ldh, 0, D, 0};
    pg8::StaticOrder S; S.init(g.M, g.N, nb, bid);
    const int lp = layer > 0 ? layer - 1 : 0;
    EpiOut E{p.out, (float*)(p.ws + WS_CTXV), p.in[0], p.in[2], (const float*)(p.ws + WS_MOD) + (size_t)(layer * 3) * 6144 + 4096, (const float*)(p.ws + WS_STATS),
             p.in[6] + (size_t)lp * D, p.in[7] + (size_t)lp * D, layer > 0 ? 1 : 0, row_base};
    pg8::gemm_phase(lds, g, S, E);
}
DI void phase5(const Params& p, LAS unsigned char* lds3) {
    const int bid = (int)blockIdx.x, nb = (int)gridDim.x;
    if (bid < 16) { phase_mix_gla(p, 0, TL, R, bid, 16); mini_barrier((unsigned*)(p.ws + WS_BAR) + 3648, 16u); gemm_out(p, 0, TL, TC, bid, 16, lds3); }
    else phase_mix_gla(p, 0, 0, TL, bid - 16, nb - 16);
}
DI void phase7(const Params& p, LAS unsigned char* lds3) {
    const int bid = (int)blockIdx.x, nb = (int)gridDim.x;
    if (bid < 32) {
        phase_norm(p, 1, 0, TL, R, bid, 32); mini_barrier((unsigned*)(p.ws + WS_BAR) + 3712, 32u);
        pg8::Gemm g{(const bf16_t*)(p.ws + WS_U) + (size_t)TL * D, (const bf16_t*)(p.ws + WS_WIN), TC, HO, D, D, 0, D, 0};
        pg8::StaticOrder S; S.init(g.M, g.N, 32, bid);
        EpiStoreBf16 E{(bf16_t*)(p.ws + WS_H) + (size_t)TL * HO, HO};
        pg8::gemm_phase(lds3, g, S, E);
    } else phase_norm(p, 1, 0, 0, TL, bid - 32, nb - 32);
}
DI void phase9(const Params& p, LAS unsigned char* lds3) {
    const int bid = (int)blockIdx.x, nb = (int)gridDim.x;
    if (bid < 16) { phase_poolmix(p, 0, TL, R, bid, 16); mini_barrier((unsigned*)(p.ws + WS_BAR) + 3776, 16u); gemm_out(p, 1, TL, TC, bid, 16, lds3); }
    else phase_poolmix(p, 0, 0, TL, bid - 16, nb - 16);
}

DI Params load_params() {
#if defined(__HIP_DEVICE_COMPILE__)
    typedef const Params __attribute__((address_space(4))) CParams;
    CParams* kp = (CParams*)__builtin_amdgcn_kernarg_segment_ptr(); asm volatile("" : "+s"(kp)); return *kp;
#else
    return Params{};
#endif
}
__global__ void __launch_bounds__(512, 2) mega(Params p0) {
    extern __shared__ __attribute__((aligned(16))) unsigned char shm[];
    LAS unsigned char* lds3 = (LAS unsigned char*)shm;
    const int ph_lo = p0.ph_lo, ph_hi = p0.ph_hi;
    volatile LAS unsigned* xst = (volatile LAS unsigned*)(lds3 + LDS_MAIN);
    if (threadIdx.x < 4) xst[threadIdx.x] = 0u;
    __syncthreads();
    const XcdBarrier xb = xcd_barrier_post((unsigned*)(p0.ws + WS_BAR), xst);
#define PH(k, ...) if (ph_lo <= (k) && (k) < ph_hi) { if ((k) > ph_lo) { if (ph_hi == 0x7fffffff) cg::this_grid().sync(); else xcd_barrier(xb); } \
        const Params p = load_params(); __VA_ARGS__; if ((k) == DUP) { xcd_barrier(xb); __VA_ARGS__; } }
    PH(0, phase_mod(p, shm); phase_convert(p, 0, shm, 3, (int)blockIdx.x, (int)gridDim.x))
    PH(1, phase_norm(p, 0, 0, 0, R, (int)blockIdx.x, (int)gridDim.x))
    PH(2, gemm_in_even(p, 0, lds3))
    PH(3, phase_prep(p, 0, shm))
    PH(4, phase_scan(p, lds3, shm, 0, R, 1))
    PH(5, phase5(p, lds3))
    PH(6, gemm_out(p, 0, 0, TL, (int)blockIdx.x, (int)gridDim.x, lds3))
    PH(7, phase7(p, lds3))
    PH(8, gemm_in_odd(p, TL, lds3))
    PH(9, phase9(p, lds3))
    PH(11, gemm_out(p, 1, 0, TL, (int)blockIdx.x, (int)gridDim.x, lds3))
    PH(12, phase_norm(p, 1, 1, 0, R, (int)blockIdx.x, (int)gridDim.x))
    PH(13, gemm_in_even(p, 2, lds3))
    PH(14, phase_prep(p, 1, shm))
    PH(15, phase_scan(p, lds3, shm, 1, TL, 3))
    PH(16, phase_mix_gla(p, 1, 0, TL, (int)blockIdx.x, (int)gridDim.x))
    PH(17, gemm_out(p, 2, 0, TL, (int)blockIdx.x, (int)gridDim.x, lds3))
    PH(18, phase_norm(p, 1, 2, 0, TL, (int)blockIdx.x, (int)gridDim.x))
    PH(19, gemm_in_odd(p, TL, lds3))
    PH(20, phase_poolmix(p, 1, 0, TL, (int)blockIdx.x, (int)gridDim.x))
    PH(22, gemm_out(p, 3, 0, TL, (int)blockIdx.x, (int)gridDim.x, lds3))
    PH(23, phase_norm(p, 2, 3, 0, TL, (int)blockIdx.x, (int)gridDim.x))
#undef PH
}

extern "C" void kernel_launch(void* const* d_in, const int* in_sizes, int n_in, void* d_out, int out_size, void* d_ws, size_t ws_size, hipStream_t stream) {
    static int grid = 0;
    if (grid == 0) {
        if (n_in != 20 || ws_size < WS_END) { fprintf(stderr, "kernel_launch: unexpected n_in %d / ws_size %zu\n", n_in, ws_size); grid = -1; return; }
        int dev = 0, cus = 0, per_cu = 0;
        hipGetDevice(&dev);
        hipDeviceGetAttribute(&cus, hipDeviceAttributeMultiprocessorCount, dev);
        if (hipFuncSetAttribute((const void*)mega, hipFuncAttributeMaxDynamicSharedMemorySize, LDS_BYTES) != hipSuccess) { fprintf(stderr, "hipFuncSetAttribute failed\n"); grid = -1; return; }
        if (hipOccupancyMaxActiveBlocksPerMultiprocessor(&per_cu, (const void*)mega, 512, LDS_BYTES) != hipSuccess || per_cu < 1) { fprintf(stderr, "occupancy query: %d\n", per_cu); per_cu = 1; }
        (void)hipGetLastError();
        grid = cus * per_cu;
    }
    if (grid < 0) return;
    Params p{};
    for (int i = 0; i < 20; ++i) p.in[i] = (const float*)d_in[i];
    p.out = (float*)d_out; p.ws = (unsigned char*)d_ws;
    (void)hipMemsetAsync((char*)d_ws + WS_BAR, 0, 4096 * 4, stream);
#if MULTI
    for (int ph = 0; ph < NPHASE; ++ph) {
        p.ph_lo = ph; p.ph_hi = ph + 1;
        hipLaunchKernelGGL(mega, dim3(grid), dim3(512), LDS_BYTES, stream, p);
    }
#else
    p.ph_lo = 0; p.ph_hi = NPHASE;
    void* args[] = {&p};
    hipError_t e = hipLaunchCooperativeKernel((const void*)mega, dim3(grid), dim3(512), args, LDS_BYTES, stream);
    if (e != hipSuccess) fprintf(stderr, "cooperative launch failed: %s (grid %d)\n", hipGetErrorString(e), grid);
#endif
}
```

```cpp
#include <hip/hip_runtime.h>
#include <hip/hip_cooperative_groups.h>
#include <cstdio>
namespace cg = cooperative_groups;

#ifndef MULTI
#define MULTI 0
#endif
#define DUP -1

#define DI __device__ __forceinline__
#define LAS __attribute__((address_space(3)))
typedef unsigned short bf16_t;
typedef short bf16x8 __attribute__((ext_vector_type(8)));
typedef float f32x2 __attribute__((ext_vector_type(2)));
typedef float f32x4 __attribute__((ext_vector_type(4)));
typedef float f32x16 __attribute__((ext_vector_type(16)));
typedef unsigned u32x2 __attribute__((ext_vector_type(2)));
typedef unsigned u32x4 __attribute__((ext_vector_type(4)));
typedef __bf16 bfv2 __attribute__((ext_vector_type(2)));

constexpr int D = 2048, TL = 32768, TC = 512, R = TL + TC, NCH = R / 64;
constexpr int HE = 8448, HON = 4096, HO = 4160;
constexpr float ALPHA = 1.6817928305074290f;
constexpr float LN_EPS = 1e-5f;
constexpr size_t MB = 1u << 20;
constexpr size_t WS_MOD = 0, WS_STATS = 1 * MB, WS_CTXV = 2 * MB, WS_WIN = 6 * MB, WS_WPOOL = 40 * MB, WS_WOUT = 42 * MB,
                 WS_U = 50 * MB, WS_H = 180 * MB, WS_KH = 717 * MB, WS_AM = 847 * MB, WS_DD = 880 * MB, WS_VT = 885 * MB, WS_BAR = 950 * MB, WS_WINB = 952 * MB, WS_WOUT_B = 960 * MB, WS_WIN_B = 968 * MB, WS_WOUT_C = 1002 * MB, WS_END = 1010 * MB;
constexpr int LDS_MAIN = 143360, LDS_BYTES = LDS_MAIN + 16;
constexpr int NPHASE = 24;

struct Params {
    const float* in[20];
    float* out;
    unsigned char* ws;
    int ph_lo, ph_hi;
};

DI float bf2f(bf16_t b) { return __uint_as_float(((unsigned)b) << 16); }
DI unsigned pk2(float lo, float hi) { f32x2 v = {lo, hi}; bfv2 b = __builtin_convertvector(v, bfv2); return __builtin_bit_cast(unsigned, b); }
DI bf16_t f2bf(float f) { return (bf16_t)(pk2(f, 0.f) & 0xffffu); }
DI float lo_bf(unsigned u) { return __uint_as_float(u << 16); }
DI float hi_bf(unsigned u) { return __uint_as_float(u & 0xffff0000u); }
DI float silu(float x) { return x / (1.f + __expf(-x)); }
DI float wave_sum(float v) {
#pragma unroll
    for (int o = 32; o > 0; o >>= 1) v += __shfl_xor(v, o);
    return v;
}
DI unsigned xb_ld(unsigned* p)              { return __hip_atomic_load(p, __ATOMIC_RELAXED, __HIP_MEMORY_SCOPE_AGENT); }
DI unsigned xb_add(unsigned* p, unsigned v) { return __hip_atomic_fetch_add(p, v, __ATOMIC_RELAXED, __HIP_MEMORY_SCOPE_AGENT); }
DI size_t win_off(int layer) { return layer == 2 ? WS_WIN_B : WS_WIN; }
DI size_t wout_off(int layer) { return layer == 0 ? WS_WOUT : (layer == 2 ? WS_WOUT_C : WS_WOUT_B); }
DI void mini_barrier(unsigned* cnt, unsigned expected) {
    asm volatile("s_waitcnt vmcnt(0)" ::: "memory");
    __syncthreads();
    if (threadIdx.x == 0) {
        __builtin_amdgcn_fence(__ATOMIC_RELEASE, "agent");
        asm volatile("s_waitcnt vmcnt(0)" ::: "memory");
        (void)xb_add(cnt, 1u);
        unsigned sp = 0; while (xb_ld(cnt) < expected) { __builtin_amdgcn_s_sleep(1); if (++sp > (1u << 22)) break; }
        __builtin_amdgcn_fence(__ATOMIC_ACQUIRE, "agent");
        asm volatile("s_waitcnt vmcnt(0)" ::: "memory");
    }
    __syncthreads();
}
DI int cond_of_row(int r) { return r < 16384 ? 0 : (r < 32768 ? 1 : 2); }
DI float* vrow(const Params& p, int r) { return r < TL ? p.out + (size_t)r * D : (float*)(p.ws + WS_CTXV) + (size_t)(r - TL) * D; }
DI const float* xin_row(const Params& p, int r) { return r < TL ? p.in[0] + (size_t)r * D : p.in[2] + (size_t)(r - TL) * D; }

namespace pg8 {
constexpr int BM = 256, BK = 64, HALF = 128, HTB = HALF * BK * 2, STAGE_BYTES = 8 * HTB, NXCD = 8, WGM = 8;
DI int lds_byte(int r, int c) { const int st = (r >> 4) * 2 + (c >> 5), rr = r & 15, cc = c & 31, ob = rr * 64 + cc * 2; return st * 1024 + (ob ^ (((ob >> 9) & 1) << 5)); }
DI void stage_rc(int b, int& Rr, int& C) { const int st = b / 1024, sb = b % 1024, swz = sb ^ (((sb >> 9) & 1) << 5); Rr = (st >> 1) * 16 + swz / 64; C = (st & 1) * 32 + (swz % 64) / 2; }
DI int perm32(int rho) { const int n = rho >> 4, i = rho & 15; return 8 * (i >> 2) + 4 * n + (i & 3); }
struct Unit { int pm, pn; };
struct Gemm { const bf16_t* A; const bf16_t* Bt; int M, N, K, lda, agroup, ldb, bgroup; };
struct StaticOrder {
    int nM, nN, nwg, G, c;
    DI void init(int M, int N, int G_, int c_) { nM = M / BM; nN = N / BM; nwg = nM * nN; G = G_; c = c_; }
    DI bool next(int i, Unit& u) const {
        const long L = (long)i * G + c; if (L >= nwg) return false;
        int wgid = (int)L; { const int q = nwg / NXCD, r = nwg % NXCD, xcd = wgid % NXCD, off = wgid / NXCD; wgid = (xcd < r ? xcd * (q + 1) : r * (q + 1) + (xcd - r) * q) + off; }
        const int nig = WGM * nN, gid = wgid / nig, fm = gid * WGM, gsz = (nM - fm) < WGM ? (nM - fm) : WGM;
        u.pm = fm + ((wgid % nig) % gsz); u.pn = (wgid % nig) / gsz; return true;
    }
};

template <class Epi>
DI void gemm_phase(LAS unsigned char* lds, const Gemm g, const StaticOrder& S, const Epi& E) {
    const int tid = threadIdx.x, wid = __builtin_amdgcn_readfirstlane(tid >> 6), lane = tid & 63, wr = wid >> 2, wc = wid & 3, fr = lane & 15, fq = lane >> 4;
    const int K = g.K, nt = K / BK, lda = g.lda, ldb = g.ldb;
    unsigned voffA[2], voffB[2];
#pragma unroll
    for (int i = 0; i < 2; ++i) { int Rr, C; stage_rc(tid * 16 + i * 8192, Rr, C); const int Rb = Epi::PERM ? ((Rr & ~31) + perm32(Rr & 31)) : Rr;
        voffA[i] = (unsigned)(Rr * lda + C) * 2u; voffB[i] = (unsigned)(Rb * ldb + C) * 2u; }
    const size_t kstep = (size_t)(BK * 2);
    const size_t hstepA = (size_t)HALF * lda * 2, hstepB = (size_t)HALF * ldb * 2;
    const size_t tstepA = 2 * hstepA, tstepB = 2 * hstepB;
    const unsigned ldsw = (unsigned)wid * 1024u;
    const int aoff = lds_byte(wr * 64 + fr, fq * 8), boff = lds_byte(wc * 32 + fr, fq * 8);
#define PG8_SA(b, h) (((b) * 2 + (h)) * HTB)
#define PG8_SB(b, h) ((4 + (b) * 2 + (h)) * HTB)
#define PG8_STAGE(bufoff, gbase, voff) do { _Pragma("unroll") for (int _i = 0; _i < 2; ++_i) \
        __builtin_amdgcn_global_load_lds((const unsigned*)((const char*)(gbase) + (voff)[_i]), (LAS unsigned*)(lds + (bufoff) + ldsw + _i * 8192), 16, 0, 0); } while (0)
#define PG8_LDA(dst, b, h) do { _Pragma("unroll") for (int m = 0; m < 4; ++m) _Pragma("unroll") for (int k = 0; k < 2; ++k) dst[m][k] = *(const LAS bf16x8*)(lds + PG8_SA(b, h) + aoff + m * 2048 + k * 1024); } while (0)
#define PG8_LDB(dst, b, h) do { _Pragma("unroll") for (int n = 0; n < 2; ++n) _Pragma("unroll") for (int k = 0; k < 2; ++k) dst[n][k] = *(const LAS bf16x8*)(lds + PG8_SB(b, h) + boff + n * 2048 + k * 1024); } while (0)
#define PG8_MMA(ai, bj, At, Bt) do { __builtin_amdgcn_s_setprio(1); _Pragma("unroll") for (int m = 0; m < 4; ++m) _Pragma("unroll") for (int n = 0; n < 2; ++n) _Pragma("unroll") for (int k = 0; k < 2; ++k) \
        acc[ai][bj][m][n] = __builtin_amdgcn_mfma_f32_16x16x32_bf16(Bt[n][k], At[m][k], acc[ai][bj][m][n], 0, 0, 0); __builtin_amdgcn_s_setprio(0); } while (0)
#define PG8_WAIT_V(n) asm volatile("s_waitcnt vmcnt(" #n ")" ::: "memory")
#define PG8_WAIT_L(n) asm volatile("s_waitcnt lgkmcnt(" #n ")" ::: "memory")
#define PG8_BAR __builtin_amdgcn_s_barrier()
#define PG8_SCHED __builtin_amdgcn_sched_barrier(0)
#define PG8_ABASE(u) ((const char*)g.A + (size_t)(u).pm * tstepA + (g.agroup ? (size_t)((u).pn >> 1) * 1024 : (size_t)0))
#define PG8_BBASE(u) ((const char*)g.Bt + (size_t)(u).pn * tstepB + (g.bgroup ? (size_t)((u).pm >> 1) * 1024 : (size_t)0))
    Unit cur, nxt; int ui = 0;
    if (!S.next(0, cur)) return;
    f32x4 acc[2][2][4][2];
#pragma unroll
    for (int a = 0; a < 2; ++a)
#pragma unroll
        for (int b = 0; b < 2; ++b)
#pragma unroll
            for (int m = 0; m < 4; ++m)
#pragma unroll
                for (int n = 0; n < 2; ++n) acc[a][b][m][n] = (f32x4){0.f, 0.f, 0.f, 0.f};
    bf16x8 At[4][2], B0[2][2], B1[2][2];
    const char* cA = PG8_ABASE(cur); const char* cB = PG8_BBASE(cur);
    PG8_STAGE(PG8_SB(0, 0), cB, voffB); PG8_STAGE(PG8_SA(0, 0), cA, voffA); PG8_STAGE(PG8_SB(0, 1), cB + hstepB, voffB); PG8_STAGE(PG8_SA(0, 1), cA + hstepA, voffA);
    if (wr == 1) PG8_BAR;
    PG8_WAIT_V(4); PG8_BAR;
    PG8_STAGE(PG8_SB(1, 0), cB + kstep, voffB); PG8_STAGE(PG8_SA(1, 0), cA + kstep, voffA); PG8_STAGE(PG8_SB(1, 1), cB + hstepB + kstep, voffB);
    PG8_WAIT_V(6); PG8_BAR;
    for (;;) {
        const bool has_next = S.next(ui + 1, nxt);
        const char* nA = has_next ? PG8_ABASE(nxt) : cA; const char* nB = has_next ? PG8_BBASE(nxt) : cB;
        for (int t = 0; t < nt; t += 2) {
            const bool last = (t == nt - 2);
            const char* a1 = cA + (size_t)(t + 1) * kstep;
            const char* a2 = last ? nA : cA + (size_t)(t + 2) * kstep; const char* b2 = last ? nB : cB + (size_t)(t + 2) * kstep;
            const char* a3 = a2 + kstep; const char* b3 = b2 + kstep;
            PG8_LDB(B0, 0, 0); PG8_SCHED; PG8_LDA(At, 0, 0); PG8_STAGE(PG8_SA(1, 1), a1 + hstepA, voffA);
            PG8_WAIT_L(8); PG8_BAR; PG8_WAIT_L(0); PG8_MMA(0, 0, At, B0); PG8_BAR; PG8_SCHED;
            PG8_LDB(B1, 0, 1); PG8_STAGE(PG8_SB(0, 0), b2, voffB);
            PG8_BAR; PG8_WAIT_L(0); PG8_MMA(0, 1, At, B1); PG8_BAR;
            PG8_LDA(At, 0, 1); PG8_STAGE(PG8_SA(0, 0), a2, voffA);
            PG8_BAR; PG8_WAIT_L(0); PG8_MMA(1, 0, At, B0); PG8_BAR; PG8_SCHED;
            PG8_STAGE(PG8_SB(0, 1), b2 + hstepB, voffB);
            PG8_WAIT_V(6); PG8_BAR; PG8_MMA(1, 1, At, B1); PG8_BAR;
            PG8_LDB(B0, 1, 0); PG8_SCHED; PG8_LDA(At, 1, 0); PG8_STAGE(PG8_SA(0, 1), a2 + hstepA, voffA);
            PG8_WAIT_L(8); PG8_BAR; PG8_WAIT_L(0); PG8_MMA(0, 0, At, B0); PG8_BAR; PG8_SCHED;
            PG8_LDB(B1, 1, 1); PG8_STAGE(PG8_SB(1, 0), b3, voffB);
            PG8_BAR; PG8_WAIT_L(0); PG8_MMA(0, 1, At, B1); PG8_BAR;
            PG8_LDA(At, 1, 1); PG8_STAGE(PG8_SA(1, 0), a3, voffA);
            PG8_BAR; PG8_WAIT_L(0); PG8_MMA(1, 0, At, B0); PG8_BAR; PG8_SCHED;
            PG8_STAGE(PG8_SB(1, 1), b3 + hstepB, voffB);
            PG8_WAIT_V(6); PG8_BAR; PG8_MMA(1, 1, At, B1); PG8_BAR;
        }
        E(acc, cur, wr, wc, fr, fq);
        if (!has_next) break;
#pragma unroll
        for (int a = 0; a < 2; ++a)
#pragma unroll
            for (int b = 0; b < 2; ++b)
#pragma unroll
                for (int m = 0; m < 4; ++m)
#pragma unroll
                    for (int n = 0; n < 2; ++n) acc[a][b][m][n] = (f32x4){0.f, 0.f, 0.f, 0.f};
        cur = nxt; cA = nA; cB = nB; ++ui;
    }
    PG8_WAIT_V(0);
    if (wr == 0) PG8_BAR;
    PG8_BAR;
#undef PG8_SA
#undef PG8_SB
#undef PG8_STAGE
#undef PG8_LDA
#undef PG8_LDB
#undef PG8_MMA
#undef PG8_WAIT_V
#undef PG8_WAIT_L
#undef PG8_BAR
#undef PG8_SCHED
#undef PG8_ABASE
#undef PG8_BBASE
}
}

struct EpiStoreBf16 {
    static constexpr bool PERM = true;
    bf16_t* O; int ldc;
    DI void operator()(const f32x4 (&acc)[2][2][4][2], const pg8::Unit& u, int wr, int wc, int fr, int fq) const {
        const int row0 = u.pm * 256 + wr * 64 + fr, col0 = u.pn * 256 + wc * 32 + 8 * fq;
#pragma unroll
        for (int ai = 0; ai < 2; ++ai)
#pragma unroll
            for (int m = 0; m < 4; ++m) { bf16_t* rowp = O + (size_t)(row0 + ai * 128 + m * 16) * ldc + col0;
#pragma unroll
                for (int bj = 0; bj < 2; ++bj) { const f32x4 v0 = acc[ai][bj][m][0], v1 = acc[ai][bj][m][1];
                    u32x4 w; w.x = pk2(v0[0], v0[1]); w.y = pk2(v0[2], v0[3]); w.z = pk2(v1[0], v1[1]); w.w = pk2(v1[2], v1[3]);
                    *(u32x4*)(rowp + bj * 128) = w; } }
    }
};
struct EpiPool {
    static constexpr bool PERM = true;
    bf16_t* O; int ldc; const float* ps;
    DI void operator()(const f32x4 (&acc)[2][2][4][2], const pg8::Unit& u, int wr, int wc, int fr, int fq) const {
        const int row0 = u.pm * 256 + wr * 64 + fr, col0 = u.pn * 256 + wc * 32 + 8 * fq;
#pragma unroll
        for (int bj = 0; bj < 2; ++bj) {
            const f32x4 p0 = *(const f32x4*)(ps + col0 + bj * 128), p1 = *(const f32x4*)(ps + col0 + bj * 128 + 4);
#pragma unroll
            for (int ai = 0; ai < 2; ++ai)
#pragma unroll
                for (int m = 0; m < 4; ++m) { bf16_t* ptr = O + (size_t)(row0 + ai * 128 + m * 16) * ldc + col0 + bj * 128;
                    const u32x4 gr = *(const u32x4*)ptr; const f32x4 v0 = acc[ai][bj][m][0], v1 = acc[ai][bj][m][1];
                    u32x4 w;
                    w.x = pk2(v0[0] * p0[0] * silu(lo_bf(gr.x)), v0[1] * p0[1] * silu(hi_bf(gr.x)));
                    w.y = pk2(v0[2] * p0[2] * silu(lo_bf(gr.y)), v0[3] * p0[3] * silu(hi_bf(gr.y)));
                    w.z = pk2(v1[0] * p1[0] * silu(lo_bf(gr.z)), v1[1] * p1[1] * silu(hi_bf(gr.z)));
                    w.w = pk2(v1[2] * p1[2] * silu(lo_bf(gr.w)), v1[3] * p1[3] * silu(hi_bf(gr.w)));
                    *(u32x4*)ptr = w; }
        }
    }
};
struct EpiOut {
    static constexpr bool PERM = false;
    float* out; float* ctxv; const float* xin; const float* cin; const float* gt0; const float* stats; const float* lg; const float* lb; int mode; int row_base;
    DI void operator()(const f32x4 (&acc)[2][2][4][2], const pg8::Unit& u, int wr, int wc, int fr, int fq) const {
        const int rowt = row_base + u.pm * 256, col0 = u.pn * 256 + wc * 32 + 4 * fq, rl = wr * 64 + fr;
        const int cd = cond_of_row(rowt);
        const float* gtp = gt0 + (size_t)cd * 6144;
        float* dbase = rowt < TL ? out + (size_t)rowt * D : ctxv + (size_t)(rowt - TL) * D;
        const float* sbase = mode ? (const float*)dbase : (rowt < TL ? xin + (size_t)rowt * D : cin + (size_t)(rowt - TL) * D);
#pragma unroll
        for (int bj = 0; bj < 2; ++bj) {
            f32x4 gv[2], gg[2], bb[2], xv[2][8];
#pragma unroll
            for (int n = 0; n < 2; ++n) {
                const int c = col0 + bj * 128 + n * 16;
                gv[n] = *(const f32x4*)(gtp + c);
                gg[n] = (f32x4){1.f, 1.f, 1.f, 1.f}; bb[n] = (f32x4){0.f, 0.f, 0.f, 0.f};
                if (mode) { gg[n] = *(const f32x4*)(lg + c); bb[n] = *(const f32x4*)(lb + c); }
#pragma unroll
                for (int q = 0; q < 8; ++q) { const int rr = rl + (q >> 2) * 128 + (q & 3) * 16; xv[n][q] = *(const f32x4*)(sbase + (size_t)rr * D + c); }
            }
#pragma unroll
            for (int n = 0; n < 2; ++n) {
                const int c = col0 + bj * 128 + n * 16;
#pragma unroll
                for (int q = 0; q < 8; ++q) {
                    const int rr = rl + (q >> 2) * 128 + (q & 3) * 16;
                    f32x4 x = xv[n][q];
                    if (mode) { const float mu = stats[2 * (rowt + rr)], rs = stats[2 * (rowt + rr) + 1]; x = (x - mu) * rs * gg[n] + bb[n]; }
                    *(f32x4*)(dbase + (size_t)rr * D + c) = ALPHA * x + gv[n] * acc[q >> 2][bj][q & 3][n];
                }
            }
        }
    }
};

DI void phase_mod(const Params& p, unsigned char* lds) {
    float* s = (float*)lds;
    float* part = s + 3 * 2048;
    float* mod = (float*)(p.ws + WS_MOD);
    const int tid = threadIdx.x;
    for (int i = tid; i < 3 * 2048; i += 512) { const int cd = i >> 11, k = i & 2047; const float v = cd < 2 ? p.in[1][cd * 2048 + k] : p.in[3][k]; s[i] = silu(v); }
    __syncthreads();
    const int cgp = tid & 15, kr = tid >> 4;
    for (int item = blockIdx.x; item < 4 * 96; item += gridDim.x) {
        const int l = item / 96, nb = item % 96;
        const float* w = p.in[4] + (size_t)l * 2048 * 6144 + nb * 64 + cgp * 4;
        f32x4 a0 = {0.f, 0.f, 0.f, 0.f}, a1 = a0, a2 = a0;
#pragma unroll 8
        for (int i = 0; i < 64; ++i) { const int k = kr + 32 * i; const f32x4 wv = *(const f32x4*)(w + (size_t)k * 6144); a0 += wv * s[k]; a1 += wv * s[2048 + k]; a2 += wv * s[4096 + k]; }
        *(f32x4*)(part + (kr * 3 + 0) * 64 + cgp * 4) = a0;
        *(f32x4*)(part + (kr * 3 + 1) * 64 + cgp * 4) = a1;
        *(f32x4*)(part + (kr * 3 + 2) * 64 + cgp * 4) = a2;
        __syncthreads();
        if (tid < 192) { const int cd = tid >> 6, n = tid & 63; float acc = p.in[5][l * 6144 + nb * 64 + n];
            for (int q = 0; q < 32; ++q) acc += part[(q * 3 + cd) * 64 + n];
            mod[(size_t)(l * 3 + cd) * 6144 + nb * 64 + n] = acc; }
        __syncthreads();
    }
}

DI void conv_tile(const float* src, int ld_src, int src_col, int k0, bf16_t* dst, int ld_dst, int n0, unsigned char* lds) {
    bf16_t* t = (bf16_t*)lds;
    const int tid = threadIdx.x;
    const int col = tid & 31, kr = tid >> 5;
#pragma unroll 4
    for (int i = 0; i < 16; ++i) { const int k = kr + 16 * i; const float v = src_col >= 0 ? src[(size_t)(k0 + k) * ld_src + src_col + col] : 0.f; t[col * 264 + k] = f2bf(v); }
    __syncthreads();
    const int n = tid >> 4, ks = (tid & 15) * 16;
    const u32x4 a = *(const u32x4*)(t + n * 264 + ks), b = *(const u32x4*)(t + n * 264 + ks + 8);
    bf16_t* o = dst + (size_t)(n0 + n) * ld_dst + k0 + ks;
    *(u32x4*)o = a; *(u32x4*)(o + 8) = b;
    __syncthreads();
}
DI int even_src_col(int n) {
    if (n >= 8224) return -1;
    if (n >= 8192) return 2048 + (n - 8192);
    const int seg = n >> 10; const int d = seg < 2 ? 0 : ((seg == 2 || seg == 7) ? 32 : (seg == 6 ? -3040 : 1056));
    return n + d;
}
DI void phase_convert(const Params& p, int layer, unsigned char* lds, int parts, int bid, int nb) {
    const int j = layer >> 1;
    bf16_t* WIN = (bf16_t*)(p.ws + win_off(layer)); bf16_t* WPOOL = (bf16_t*)(p.ws + WS_WPOOL); bf16_t* WOUT = (bf16_t*)(p.ws + wout_off(layer));
    if ((layer & 1) == 0) {
        const int nA = (parts & 1) ? 264 * 8 : 0, nB = (parts & 2) ? 64 * 8 : 0;
        for (int idx = bid; idx < nA + nB; idx += nb) {
            if (idx < nA) { const int nbk = idx >> 3, kt = idx & 7; conv_tile(p.in[8] + (size_t)j * 2048 * 8224, 8224, even_src_col(32 * nbk), 256 * kt, WIN, 2048, 32 * nbk, lds); }
            else { const int i2 = idx - nA, nbk = i2 >> 3, kt = i2 & 7; conv_tile(p.in[15] + (size_t)j * 2048 * 2048, 2048, 32 * nbk, 256 * kt, WOUT, 2048, 32 * nbk, lds); }
        }
    } else {
        const int nA = (parts & 1) ? 64 * 8 : 0, nP = (parts & 1) ? 128 : 0, nB = (parts & 2) ? 64 * 8 : 0;
        for (int idx = bid; idx < nA + nP + nB; idx += nb) {
            if (idx < nA) { const int nbk = 64 + (idx >> 3), kt = idx & 7; conv_tile(p.in[16] + (size_t)j * 2048 * 4096, 4096, 32 * nbk, 256 * kt, WIN, 2048, 32 * nbk, lds); }
            else if (idx < nA + nP) { const int i2 = idx - nA, gq = i2 >> 5, nbk = (i2 >> 1) & 15, kt = i2 & 1;
                conv_tile(p.in[17] + (size_t)(j * 4 + gq) * 512 * 512, 512, 32 * nbk, 256 * kt, WPOOL, 512, gq * 512 + 32 * nbk, lds); }
            else { const int i2 = idx - nA - nP, nbk = i2 >> 3, kt = i2 & 7; conv_tile(p.in[19] + (size_t)j * 2048 * 2048, 2048, 32 * nbk, 256 * kt, WOUT, 2048, 32 * nbk, lds); }
        }
        if (parts & 1) {
            const float* srcw = p.in[16] + (size_t)j * 2048 * 4096; bf16_t* WB = (bf16_t*)(p.ws + WS_WINB);
            for (int e = (bid * 512 + (int)threadIdx.x) * 4; e < 2048 * 2048; e += nb * 512 * 4) {
                const int k = e >> 11, c = e & 2047; const f32x4 v = *(const f32x4*)(srcw + (size_t)k * 4096 + c);
                u32x2 w; w.x = pk2(v[0], v[1]); w.y = pk2(v[2], v[3]); *(u32x2*)(WB + e) = w; }
        }
    }
}

DI void phase_norm(const Params& p, int mode, int l, int row_lo, int nrows, int bid, int nb) {
    const int lane = threadIdx.x & 63, wave = threadIdx.x >> 6;
    const int gw = bid * 8 + wave, nw = nb * 8;
    const float* mod = (const float*)(p.ws + WS_MOD);
    float* stats = (float*)(p.ws + WS_STATS);
    bf16_t* U = (bf16_t*)(p.ws + WS_U);
    const int lnext = mode == 0 ? 0 : l + 1;
    f32x4 vn[8];
    if (row_lo + gw < nrows) { const int r0 = row_lo + gw; const float* src0 = mode == 0 ? xin_row(p, r0) : (const float*)vrow(p, r0);
#pragma unroll
        for (int i = 0; i < 8; ++i) vn[i] = *(const f32x4*)(src0 + i * 256 + lane * 4); }
    for (int r = row_lo + gw; r < nrows; r += nw) {
        f32x4 v[8];
#pragma unroll
        for (int i = 0; i < 8; ++i) v[i] = vn[i];
        { const int rn = r + nw < nrows ? r + nw : r;
          const float* srcn = mode == 0 ? xin_row(p, rn) : (const float*)vrow(p, rn);
#pragma unroll
          for (int i = 0; i < 8; ++i) vn[i] = *(const f32x4*)(srcn + i * 256 + lane * 4); }
        if (mode != 0) {
            float s = 0.f;
#pragma unroll
            for (int i = 0; i < 8; ++i) s += v[i][0] + v[i][1] + v[i][2] + v[i][3];
            s = wave_sum(s); const float mu = s * (1.f / 2048.f);
            float q = 0.f;
#pragma unroll
            for (int i = 0; i < 8; ++i) { const f32x4 d = v[i] - mu; q += d[0] * d[0] + d[1] * d[1] + d[2] * d[2] + d[3] * d[3]; }
            q = wave_sum(q); const float rs = rsqrtf(q * (1.f / 2048.f) + LN_EPS);
            if (mode == 1 && lane == 0) { stats[2 * r] = mu; stats[2 * r + 1] = rs; }
            const float* lg = p.in[6] + (size_t)l * D; const float* lb = p.in[7] + (size_t)l * D;
#pragma unroll
            for (int i = 0; i < 8; ++i) { const f32x4 gg = *(const f32x4*)(lg + i * 256 + lane * 4), bb = *(const f32x4*)(lb + i * 256 + lane * 4); v[i] = (v[i] - mu) * rs * gg + bb; }
        }
        if (mode == 2) {
            float* dst = p.out + (size_t)r * D;
#pragma unroll
            for (int i = 0; i < 8; ++i) *(f32x4*)(dst + i * 256 + lane * 4) = v[i];
        } else {
            const int cd = cond_of_row(r);
            const float* sh = mod + (size_t)(lnext * 3 + cd) * 6144; const float* sc = sh + 2048;
            bf16_t* dst = U + (size_t)r * D;
#pragma unroll
            for (int i = 0; i < 8; ++i) { const int c = i * 256 + lane * 4; const f32x4 a = *(const f32x4*)(sh + c), b = *(const f32x4*)(sc + c);
                const f32x4 o = v[i] * (1.f + b) + a; u32x2 w; w.x = pk2(o[0], o[1]); w.y = pk2(o[2], o[3]); *(u32x2*)(dst + c) = w; }
        }
    }
}

template <int DIR>
DI float prep_gate_loop(const float* r_s, bf16_t* qt, bf16_t* kt, const float (&w)[16], float bias, int kk) {
    constexpr float LOG2E = 1.4426950408889634f;
    float g = 0.f;
    for (int blk = 0; blk < 4; ++blk) {
        float la[16];
#pragma unroll
        for (int i = 0; i < 16; ++i) {
            const int tt = blk * 16 + i; const int t = DIR ? 63 - tt : tt;
            const f32x4* rr = (const f32x4*)(r_s + t * 32 + DIR * 16);
            const f32x4 r0 = rr[0], r1 = rr[1], r2 = rr[2], r3 = rr[3];
            float s0 = __builtin_fmaf(r0[0], w[0], bias), s1 = r0[1] * w[1], s2 = r0[2] * w[2], s3 = r0[3] * w[3];
            s0 = __builtin_fmaf(r1[0], w[4], s0); s1 = __builtin_fmaf(r1[1], w[5], s1); s2 = __builtin_fmaf(r1[2], w[6], s2); s3 = __builtin_fmaf(r1[3], w[7], s3);
            s0 = __builtin_fmaf(r2[0], w[8], s0); s1 = __builtin_fmaf(r2[1], w[9], s1); s2 = __builtin_fmaf(r2[2], w[10], s2); s3 = __builtin_fmaf(r2[3], w[11], s3);
            s0 = __builtin_fmaf(r3[0], w[12], s0); s1 = __builtin_fmaf(r3[1], w[13], s1); s2 = __builtin_fmaf(r3[2], w[14], s2); s3 = __builtin_fmaf(r3[3], w[15], s3);
            const float pre = (s0 + s1) + (s2 + s3);
            const float ex = __builtin_amdgcn_exp2f(-fabsf(pre) * LOG2E);
            la[i] = (fminf(pre, 0.f) * LOG2E - __builtin_amdgcn_logf(1.f + ex)) * 0.0625f;
        }
#pragma unroll
        for (int i = 0; i < 16; ++i) { g += la[i]; la[i] = g; }
#pragma unroll
        for (int i = 0; i < 16; ++i) {
            const int tt = blk * 16 + i; const int t = DIR ? 63 - tt : tt;
            const float e = __builtin_amdgcn_exp2f(la[i]);
            bf16_t* qp = qt + (DIR * 64 + t) * 264 + kk; bf16_t* kp = kt + (DIR * 64 + t) * 264 + kk;
            const float qv = bf2f(*qp), kv = bf2f(*kp);
            *qp = f2bf(qv * 0.0625f * e);
            *kp = f2bf(kv * __builtin_amdgcn_rcpf(e));
        }
    }
    return __builtin_amdgcn_exp2f(g);
}

struct PrepIn { u32x4 q[4], k[4], v[4]; u32x2 rr; float w[16]; float bias; };
DI void prep_load(PrepIn& I, const Params& p, int j, int item, int tid) {
    const bf16_t* H = (const bf16_t*)(p.ws + WS_H);
    const int c = item >> 2, h = item & 3; const size_t row0 = (size_t)c * 64;
    const int dir = tid >> 8, kk = tid & 255;
    { const int t = tid >> 3, sg = tid & 7; I.rr = *(const u32x2*)(H + (row0 + t) * HE + 8192 + sg * 4); }
    const float* wgf = p.in[9]; const float* wgb = p.in[11]; const float* bgf = p.in[10]; const float* bgb = p.in[12];
    const float* wg = (dir ? wgb : wgf) + (size_t)j * 16 * 1024 + h * 256 + kk;
#pragma unroll
    for (int i = 0; i < 16; ++i) I.w[i] = wg[i * 1024];
    I.bias = (dir ? bgb : bgf)[j * 1024 + h * 256 + kk];
#pragma unroll
    for (int it = 0; it < 4; ++it) { const int idx = it * 512 + tid; const int t = idx >> 5, seg = idx & 31;
        I.q[it] = *(const u32x4*)(H + (row0 + t) * HE + 2048 + h * 256 + seg * 8);
        I.k[it] = *(const u32x4*)(H + (row0 + t) * HE + h * 256 + seg * 8);
        I.v[it] = *(const u32x4*)(H + (row0 + t) * HE + 1024 + h * 256 + seg * 8); }
}
DI void phase_prep(const Params& p, int j, unsigned char* lds) {
    float* r_s = (float*)lds;
    bf16_t* qt = (bf16_t*)(lds + 8192);
    bf16_t* kt = qt + 2 * 64 * 264;
    const bf16_t* H = (const bf16_t*)(p.ws + WS_H);
    const int tid = threadIdx.x, lane = tid & 63, wave = tid >> 6;
    const int dir = tid >> 8, kk = tid & 255;
    PrepIn I;
    if ((int)blockIdx.x < NCH * 4) prep_load(I, p, j, blockIdx.x, tid);
    for (int item = blockIdx.x; item < NCH * 4; item += gridDim.x) {
        {
            const int t = tid >> 3, sg = tid & 7;
            f32x4 o = {lo_bf(I.rr.x), hi_bf(I.rr.x), lo_bf(I.rr.y), hi_bf(I.rr.y)}; *(f32x4*)(r_s + t * 32 + sg * 4) = o;
#pragma unroll
            for (int it = 0; it < 4; ++it) { const int idx = it * 512 + tid; const int tq = idx >> 5, seg = idx & 31;
                *(u32x4*)(qt + tq * 264 + seg * 8) = I.q[it]; *(u32x4*)(qt + (64 + tq) * 264 + seg * 8) = I.q[it];
                *(u32x4*)(kt + tq * 264 + seg * 8) = I.k[it]; *(u32x4*)(kt + (64 + tq) * 264 + seg * 8) = I.k[it]; }
        }
        float w[16];
#pragma unroll
        for (int i = 0; i < 16; ++i) w[i] = I.w[i];
        const float bias = I.bias;
        u32x4 vcur[4];
#pragma unroll
        for (int it = 0; it < 4; ++it) vcur[it] = I.v[it];
        __syncthreads();
        float dlast;
        if (dir == 0) dlast = prep_gate_loop<0>(r_s, qt, kt, w, bias, kk); else dlast = prep_gate_loop<1>(r_s, qt, kt, w, bias, kk);
        ((float*)(p.ws + WS_DD))[(size_t)(item * 2 + dir) * 256 + kk] = dlast;
        { const int nitem = item + (int)gridDim.x; prep_load(I, p, j, nitem < NCH * 4 ? nitem : item, tid); }
        {
            bf16_t* KHp = (bf16_t*)(p.ws + WS_KH) + (size_t)(item * 2 + dir) * 16384;
            const int w8 = kk >> 5, r = kk & 31;
#pragma unroll
            for (int tg = 0; tg < 8; ++tg) {
                float val[8];
#pragma unroll
                for (int i = 0; i < 8; ++i) val[i] = bf2f(kt[(dir * 64 + 8 * tg + i) * 264 + kk]) * dlast;
                u32x4 pk; pk.x = pk2(val[0], val[1]); pk.y = pk2(val[2], val[3]); pk.z = pk2(val[4], val[5]); pk.w = pk2(val[6], val[7]);
                const int s = tg >> 1, hh = tg & 1;
                *(u32x4*)(KHp + ((w8 * 4 + s) * 64 + hh * 32 + r) * 8) = pk;
            }
        }
        __syncthreads();
        {
            bf16_t* QTp = (bf16_t*)(p.ws + WS_U) + (size_t)(item * 2) * 16384;
#pragma unroll
            for (int it = 0; it < 8; ++it) {
                const int idx = it * 512 + tid; const int d2 = idx >> 11, f = (idx >> 6) & 31, ln = idx & 63;
                const int w8 = f >> 2, mb = (f >> 1) & 1, s = f & 1, rr = ln & 31, hh = ln >> 5;
                const bf16_t* sp = qt + (d2 * 64 + 32 * mb + rr) * 264 + 32 * w8 + 16 * s + 4 * hh;
                const u32x2 lo = *(const u32x2*)sp, hi = *(const u32x2*)(sp + 8);
                u32x4 o; o.x = lo.x; o.y = lo.y; o.z = hi.x; o.w = hi.y;
                *(u32x4*)(QTp + (size_t)d2 * 16384 + (f * 64 + ln) * 8) = o;
            }
        }
        float amask[4][4];
        {
            const int d2 = wave >> 2, wd = wave & 3, fr = lane & 15, fq = lane >> 4;
            f32x4 acc[4];
#pragma unroll
            for (int nb = 0; nb < 4; ++nb) acc[nb] = (f32x4){0.f, 0.f, 0.f, 0.f};
            const bf16_t* qb = qt + (d2 * 64 + 16 * wd + fr) * 264 + 8 * fq;
            const bf16_t* kb = kt + (d2 * 64 + fr) * 264 + 8 * fq;
#pragma unroll
            for (int ks = 0; ks < 8; ++ks) {
                const bf16x8 a = *(const bf16x8*)(qb + 32 * ks);
#pragma unroll
                for (int nb = 0; nb < 4; ++nb) { const bf16x8 b = *(const bf16x8*)(kb + nb * 16 * 264 + 32 * ks); acc[nb] = __builtin_amdgcn_mfma_f32_16x16x32_bf16(a, b, acc[nb], 0, 0, 0); }
            }
#pragma unroll
            for (int nb = 0; nb < 4; ++nb)
#pragma unroll
                for (int jx = 0; jx < 4; ++jx) {
                    const int i = 16 * wd + 4 * fq + jx, jt = 16 * nb + fr;
                    const bool keep = d2 ? (jt >= i) : (jt <= i);
                    amask[nb][jx] = keep ? acc[nb][jx] : 0.f;
                }
        }
        __syncthreads();
        {
#pragma unroll
            for (int it = 0; it < 4; ++it) { const int idx = it * 512 + tid; const int t = idx >> 5, seg = idx & 31; *(u32x4*)(qt + t * 264 + seg * 8) = vcur[it]; }
        }
        {
            const int d2 = wave >> 2, wd = wave & 3, fr = lane & 15, fq = lane >> 4;
#pragma unroll
            for (int nb = 0; nb < 4; ++nb)
#pragma unroll
                for (int jx = 0; jx < 4; ++jx) {
                    const int i = 16 * wd + 4 * fq + jx, jt = 16 * nb + fr;
                    const int mb = i >> 5, r = i & 31, hh = (jt >> 3) & 1, jj = jt & 7;
                    kt[d2 * 4096 + ((nb * 2 + mb) * 64 + hh * 32 + r) * 8 + jj] = f2bf(amask[nb][jx]);
                }
        }
        __syncthreads();
        {
            bf16_t* AMp = (bf16_t*)(p.ws + WS_AM) + (size_t)(item * 2) * 4096;
            *(u32x4*)(AMp + tid * 8) = *(const u32x4*)(kt + tid * 8);
            *(u32x4*)(AMp + 4096 + tid * 8) = *(const u32x4*)(kt + 4096 + tid * 8);
        }
        {
            bf16_t* VTp = (bf16_t*)(p.ws + WS_VT) + (size_t)item * 16384;
#pragma unroll
            for (int it = 0; it < 4; ++it) {
                const int idx = it * 512 + tid; const int f = idx >> 6, ln = idx & 63; const int sl = f >> 2, s = f & 3, rr = ln & 31, hh = ln >> 5;
                const bf16_t* sp = qt + (16 * s + 8 * hh) * 264 + 32 * sl + rr;
                unsigned e[8];
#pragma unroll
                for (int jj = 0; jj < 8; ++jj) e[jj] = sp[jj * 264];
                u32x4 o; o.x = e[0] | (e[1] << 16); o.y = e[2] | (e[3] << 16); o.z = e[4] | (e[5] << 16); o.w = e[6] | (e[7] << 16);
                *(u32x4*)(VTp + (f * 64 + ln) * 8) = o;
            }
        }
        __syncthreads();
    }
}

DI void mix_conv(const Params& p, int j, int nrows, int gw, int nw);
DI int scan_chunk(int n, int b, int dir) {
    if (n < 4) return 512 + 4 * b + (dir ? 3 - n : n);
    const int m = n - 4; return 256 * b + (dir ? 255 - m : m);
}
struct ScanFrags { bf16x8 qa[2][2], ka[4], aa[2]; u32x4 stage; };
DI void scan_load(ScanFrags& F, const unsigned char* ws, int c, int h, int dir, int sl, int w, int lane) {
    const size_t blk = (size_t)((c * 4 + h) * 2 + dir);
    const bf16_t* QT = (const bf16_t*)(ws + WS_U) + blk * 16384 + lane * 8;
    const bf16_t* KH = (const bf16_t*)(ws + WS_KH) + blk * 16384 + lane * 8;
    const bf16_t* AM = (const bf16_t*)(ws + WS_AM) + blk * 4096 + lane * 8;
#pragma unroll
    for (int mb = 0; mb < 2; ++mb)
#pragma unroll
        for (int s = 0; s < 2; ++s) F.qa[mb][s] = *(const bf16x8*)(QT + ((w * 2 + mb) * 2 + s) * 512);
#pragma unroll
    for (int s = 0; s < 4; ++s) F.ka[s] = *(const bf16x8*)(KH + (w * 4 + s) * 512);
#pragma unroll
    for (int mb = 0; mb < 2; ++mb) F.aa[mb] = w < 4 ? *(const bf16x8*)(AM + ((w * 2 + mb)) * 512) : (bf16x8){0, 0, 0, 0, 0, 0, 0, 0};
    const int tid = w * 64 + lane;
    if (tid < 256) F.stage = *(const u32x4*)((const bf16_t*)(ws + WS_VT) + (size_t)(c * 4 + h) * 16384 + sl * 2048 + tid * 8);
    else if (tid < 320) F.stage = *(const u32x4*)((const float*)(ws + WS_DD) + blk * 256 + (tid - 256) * 4);
}
constexpr int SCAN_VB_OFF = 73728, SCAN_DD_OFF = 73728 + 8192;
DI void scan_stage_store(const ScanFrags& F, LAS unsigned char* lds, int buf, int tid) {
    if (tid < 256) *(LAS u32x4*)(lds + SCAN_VB_OFF + buf * 4096 + tid * 16) = F.stage;
    else if (tid < 320) *(LAS u32x4*)(lds + SCAN_DD_OFF + buf * 1024 + (tid - 256) * 16) = F.stage;
}
DI bf16x8 pack8(const f32x16& x, int s) {
    u32x4 pk; pk.x = pk2(x[8 * s], x[8 * s + 1]); pk.y = pk2(x[8 * s + 2], x[8 * s + 3]); pk.z = pk2(x[8 * s + 4], x[8 * s + 5]); pk.w = pk2(x[8 * s + 6], x[8 * s + 7]);
    return __builtin_bit_cast(bf16x8, pk);
}
DI void phase_scan(const Params& p, LAS unsigned char* lds, unsigned char* ldsg, int j, int conv_rows, int next_layer) {
    bf16_t* H = (bf16_t*)(p.ws + WS_H);
    const int tid = threadIdx.x, lane = tid & 63, w = tid >> 6, r = lane & 31, hh = lane >> 5;
    if (blockIdx.x >= 128) {
        const int nbk = (int)gridDim.x - 128, bid = (int)blockIdx.x - 128;
        mix_conv(p, j, conv_rows, bid * 8 + (tid >> 6), nbk * 8);
        phase_convert(p, next_layer, ldsg, 3, bid, nbk);
        if (next_layer == 1) phase_convert(p, 2, ldsg, 3, bid, nbk);
        mini_barrier((unsigned*)(p.ws + WS_BAR) + 3520 + 64 * j, (unsigned)nbk);
        {
            pg8::Gemm g{(const bf16_t*)(p.ws + WS_WPOOL), (const bf16_t*)(p.ws + WS_WINB), 2048, 2048, 512, 512, 0, 2048, 1};
            pg8::StaticOrder S; S.init(g.M, g.N, nbk, bid);
            EpiStoreBf16 E{(bf16_t*)(p.ws + WS_WIN), 2048};
            pg8::gemm_phase(lds, g, S, E);
        }
        return;
    }
    for (int id = blockIdx.x; id < 128; id += gridDim.x) {
        const int xcd = id & 7, widx = id >> 3; const int scan = xcd * 2 + (widx >> 3), sl = widx & 7;
        const int b = scan >> 3, h = (scan >> 1) & 3, dir = scan & 1;
        f32x16 S;
#pragma unroll
        for (int i = 0; i < 16; ++i) S[i] = 0.f;
        ScanFrags cur, nxt, nn;
        scan_load(cur, p.ws, scan_chunk(0, b, dir), h, dir, sl, w, lane);
        scan_load(nxt, p.ws, scan_chunk(1, b, dir), h, dir, sl, w, lane);
        scan_stage_store(cur, lds, 0, tid);
        __syncthreads();
        for (int n = 0; n < 260; ++n) {
            const int c = scan_chunk(n, b, dir);
            scan_load(nn, p.ws, scan_chunk(n < 258 ? n + 2 : 259, b, dir), h, dir, sl, w, lane);
            const bf16x8 sb0 = pack8(S, 0), sb1 = pack8(S, 1);
            bf16x8 vb[4]; f32x4 dd[4];
            {
                unsigned vo = (unsigned)(SCAN_VB_OFF + (n & 1) * 4096 + lane * 16), dofs = (unsigned)(SCAN_DD_OFF + (n & 1) * 1024 + (32 * w + 4 * hh) * 4);
                asm volatile("" : "+v"(vo), "+v"(dofs));
#pragma unroll
                for (int s = 0; s < 4; ++s) { vb[s] = *(const LAS bf16x8*)(lds + vo + s * 1024); dd[s] = *(const LAS f32x4*)(lds + dofs + s * 32); }
            }
            const bf16x8 vw = (w & 3) == 0 ? vb[0] : ((w & 3) == 1 ? vb[1] : ((w & 3) == 2 ? vb[2] : vb[3]));
            bf16x8 aa0 = cur.aa[0], aa1 = cur.aa[1];
            unsigned rbo = (unsigned)(((n & 1) * 8 + w) * 4608 + r * 72 + hh * 8);
            asm volatile("" : "+v"(rbo));
            LAS unsigned char* rb = lds + rbo;
#pragma unroll
            for (int mb = 0; mb < 2; ++mb) {
                f32x16 o;
#pragma unroll
                for (int i = 0; i < 16; ++i) o[i] = 0.f;
                o = __builtin_amdgcn_mfma_f32_32x32x16_bf16(sb0, cur.qa[mb][0], o, 0, 0, 0);
                o = __builtin_amdgcn_mfma_f32_32x32x16_bf16(sb1, cur.qa[mb][1], o, 0, 0, 0);
                o = __builtin_amdgcn_mfma_f32_32x32x16_bf16(vw, mb ? aa1 : aa0, o, 0, 0, 0);
#pragma unroll
                for (int g = 0; g < 4; ++g) { u32x2 pk; pk.x = pk2(o[4 * g], o[4 * g + 1]); pk.y = pk2(o[4 * g + 2], o[4 * g + 3]);
                    *(LAS u32x2*)(rb + mb * 2304 + g * 16) = pk; }
            }
#pragma unroll
            for (int i = 0; i < 16; ++i) S[i] *= dd[i >> 2][i & 3];
#pragma unroll
            for (int s = 0; s < 4; ++s) S = __builtin_amdgcn_mfma_f32_32x32x16_bf16(cur.ka[s], vb[s], S, 0, 0, 0);
            scan_stage_store(nxt, lds, (n + 1) & 1, tid);
            __syncthreads();
            {
                const int i = tid >> 3, vq = (tid & 7) * 4;
                unsigned rpo = (unsigned)((n & 1) * 8 * 4608 + i * 72 + vq * 2);
                asm volatile("" : "+v"(rpo));
                const LAS unsigned char* rp = lds + rpo;
                float a0 = 0.f, a1 = 0.f, a2 = 0.f, a3 = 0.f;
#pragma unroll
                for (int ww = 0; ww < 8; ++ww) { const u32x2 q = *(const LAS u32x2*)(rp + ww * 4608); a0 += lo_bf(q.x); a1 += hi_bf(q.x); a2 += lo_bf(q.y); a3 += hi_bf(q.y); }
                u32x2 ov; ov.x = pk2(a0, a1); ov.y = pk2(a2, a3);
                *(u32x2*)(H + (size_t)(64 * c + i) * HE + (dir ? 2048 : 0) + h * 256 + 32 * sl + vq) = ov;
            }
            cur = nxt; nxt = nn;
        }
        __syncthreads();
    }
}

DI void phase_mix_gla(const Params& p, int j, int row_lo, int nrows, int bid, int nb) {
    bf16_t* H = (bf16_t*)(p.ws + WS_H);
    const int lane = threadIdx.x & 63, wave = threadIdx.x >> 6;
    const int gw = bid * 8 + wave, nw = nb * 8;
    const float* gnw = p.in[13] + (size_t)j * 256;
    for (int r = row_lo + gw; r < nrows; r += nw) {
        bf16_t* row = H + (size_t)r * HE;
        {
            const int c0 = lane * 16;
            float o[16];
            const u32x4 gq0 = *(const u32x4*)(row + 6144 + c0), gq1 = *(const u32x4*)(row + 6144 + c0 + 8);
#pragma unroll
            for (int q = 0; q < 2; ++q) { const u32x4 a = *(const u32x4*)(row + c0 + 8 * q), b = *(const u32x4*)(row + 2048 + c0 + 8 * q);
                o[8 * q + 0] = lo_bf(a.x) + lo_bf(b.x); o[8 * q + 1] = hi_bf(a.x) + hi_bf(b.x); o[8 * q + 2] = lo_bf(a.y) + lo_bf(b.y); o[8 * q + 3] = hi_bf(a.y) + hi_bf(b.y);
                o[8 * q + 4] = lo_bf(a.z) + lo_bf(b.z); o[8 * q + 5] = hi_bf(a.z) + hi_bf(b.z); o[8 * q + 6] = lo_bf(a.w) + lo_bf(b.w); o[8 * q + 7] = hi_bf(a.w) + hi_bf(b.w); }
            float ss = 0.f;
#pragma unroll
            for (int i = 0; i < 16; ++i) ss += o[i] * o[i];
#pragma unroll
            for (int m = 8; m > 0; m >>= 1) ss += __shfl_xor(ss, m);
            const float rs = rsqrtf(ss * (1.f / 256.f) + LN_EPS);
            const int vc = (lane & 15) * 16;
#pragma unroll
            for (int q = 0; q < 2; ++q) { const u32x4 gq = q ? gq1 : gq0;
                const f32x4 w0 = *(const f32x4*)(gnw + vc + 8 * q), w1 = *(const f32x4*)(gnw + vc + 8 * q + 4);
                u32x4 y;
                y.x = pk2(o[8 * q + 0] * rs * w0[0] * silu(lo_bf(gq.x)), o[8 * q + 1] * rs * w0[1] * silu(hi_bf(gq.x)));
                y.y = pk2(o[8 * q + 2] * rs * w0[2] * silu(lo_bf(gq.y)), o[8 * q + 3] * rs * w0[3] * silu(hi_bf(gq.y)));
                y.z = pk2(o[8 * q + 4] * rs * w1[0] * silu(lo_bf(gq.z)), o[8 * q + 5] * rs * w1[1] * silu(hi_bf(gq.z)));
                y.w = pk2(o[8 * q + 6] * rs * w1[2] * silu(lo_bf(gq.w)), o[8 * q + 7] * rs * w1[3] * silu(hi_bf(gq.w)));
                *(u32x4*)(row + 6144 + c0 + 8 * q) = y; }
        }
    }
}
DI void mix_conv(const Params& p, int j, int nrows, int gw, int nw) {
    bf16_t* H = (bf16_t*)(p.ws + WS_H);
    const int lane = threadIdx.x & 63;
    const float* cw = p.in[14] + (size_t)j * 3 * 1024;
    for (int r = gw; r < nrows; r += nw) {
        bf16_t* row = H + (size_t)r * HE;
        {
            const int c0 = lane * 16;
            const bool hasp = r < TL ? ((r & 63) != 0) : ((r & 255) != 0);
            const bool hasn = r < TL ? ((r & 63) != 63) : ((r & 255) != 255);
#pragma unroll
            for (int q = 0; q < 2; ++q) {
                const int cc = c0 + 8 * q;
                float u0[8], u1[8], u2[8];
                { const u32x4 a = *(const u32x4*)(row + 4096 + cc), b = *(const u32x4*)(row + 5120 + cc);
                  u1[0] = lo_bf(a.x) * lo_bf(b.x); u1[1] = hi_bf(a.x) * hi_bf(b.x); u1[2] = lo_bf(a.y) * lo_bf(b.y); u1[3] = hi_bf(a.y) * hi_bf(b.y);
                  u1[4] = lo_bf(a.z) * lo_bf(b.z); u1[5] = hi_bf(a.z) * hi_bf(b.z); u1[6] = lo_bf(a.w) * lo_bf(b.w); u1[7] = hi_bf(a.w) * hi_bf(b.w); }
                if (hasp) { const u32x4 a = *(const u32x4*)(row - HE + 4096 + cc), b = *(const u32x4*)(row - HE + 5120 + cc);
                  u0[0] = lo_bf(a.x) * lo_bf(b.x); u0[1] = hi_bf(a.x) * hi_bf(b.x); u0[2] = lo_bf(a.y) * lo_bf(b.y); u0[3] = hi_bf(a.y) * hi_bf(b.y);
                  u0[4] = lo_bf(a.z) * lo_bf(b.z); u0[5] = hi_bf(a.z) * hi_bf(b.z); u0[6] = lo_bf(a.w) * lo_bf(b.w); u0[7] = hi_bf(a.w) * hi_bf(b.w); }
                else {
#pragma unroll
                    for (int i = 0; i < 8; ++i) u0[i] = 0.f; }
                if (hasn) { const u32x4 a = *(const u32x4*)(row + HE + 4096 + cc), b = *(const u32x4*)(row + HE + 5120 + cc);
                  u2[0] = lo_bf(a.x) * lo_bf(b.x); u2[1] = hi_bf(a.x) * hi_bf(b.x); u2[2] = lo_bf(a.y) * lo_bf(b.y); u2[3] = hi_bf(a.y) * hi_bf(b.y);
                  u2[4] = lo_bf(a.z) * lo_bf(b.z); u2[5] = hi_bf(a.z) * hi_bf(b.z); u2[6] = lo_bf(a.w) * lo_bf(b.w); u2[7] = hi_bf(a.w) * hi_bf(b.w); }
                else {
#pragma unroll
                    for (int i = 0; i < 8; ++i) u2[i] = 0.f; }
                const u32x4 ab = *(const u32x4*)(row + 3072 + cc), ga = *(const u32x4*)(row + 7168 + cc);
                float abf[8] = {lo_bf(ab.x), hi_bf(ab.x), lo_bf(ab.y), hi_bf(ab.y), lo_bf(ab.z), hi_bf(ab.z), lo_bf(ab.w), hi_bf(ab.w)};
                float gaf[8] = {lo_bf(ga.x), hi_bf(ga.x), lo_bf(ga.y), hi_bf(ga.y), lo_bf(ga.z), hi_bf(ga.z), lo_bf(ga.w), hi_bf(ga.w)};
                float y[8];
#pragma unroll
                for (int hq = 0; hq < 2; ++hq) {
                    const f32x4 w0 = *(const f32x4*)(cw + cc + 4 * hq), w1 = *(const f32x4*)(cw + 1024 + cc + 4 * hq), w2 = *(const f32x4*)(cw + 2048 + cc + 4 * hq);
#pragma unroll
                    for (int i = 0; i < 4; ++i) { const int e = 4 * hq + i; y[e] = abf[e] * (w0[i] * u0[e] + w1[i] * u1[e] + w2[i] * u2[e]) * silu(gaf[e]); }
                }
                u32x4 yo; yo.x = pk2(y[0], y[1]); yo.y = pk2(y[2], y[3]); yo.z = pk2(y[4], y[5]); yo.w = pk2(y[6], y[7]);
                *(u32x4*)(row + 7168 + cc) = yo;
            }
        }
    }
}

template <int WIN>
DI void pool_item(bf16_t* H, const float* ps, int r, int gq, int lane) {
    int pos, stride, base;
    if (r < TL) { const int t = r & 16383; pos = t >> 6; stride = 64; base = r - pos * 64; }
    else { const int t = (r - TL) & 255; pos = t; stride = 1; base = r - pos; }
    const int col = gq * 512 + lane * 8;
    u32x4 v[WIN];
#pragma unroll
    for (int i = 0; i < WIN; ++i) { int q = pos - WIN / 2 + i; q = q < 0 ? 0 : (q > 255 ? 255 : q); v[i] = *(const u32x4*)(H + (size_t)(base + q * stride) * HO + col); }
    bf16_t* gp = H + (size_t)r * HO + 2048 + col;
    const u32x4 gt = *(const u32x4*)gp;
    const f32x4 p0 = *(const f32x4*)(ps + col), p1 = *(const f32x4*)(ps + col + 4);
    float acc[8];
#pragma unroll
    for (int i = 0; i < 8; ++i) acc[i] = 0.f;
#pragma unroll
    for (int i = 0; i < WIN; ++i) { const int q = pos - WIN / 2 + i; const float m = (q >= 0 && q < 256) ? 1.f : 0.f;
        acc[0] += m * lo_bf(v[i].x); acc[1] += m * hi_bf(v[i].x); acc[2] += m * lo_bf(v[i].y); acc[3] += m * hi_bf(v[i].y);
        acc[4] += m * lo_bf(v[i].z); acc[5] += m * hi_bf(v[i].z); acc[6] += m * lo_bf(v[i].w); acc[7] += m * hi_bf(v[i].w); }
    int lo = pos - WIN / 2, hi = pos + WIN - WIN / 2; lo = lo < 0 ? 0 : lo; hi = hi > 256 ? 256 : hi;
    const float inv = 1.f / (float)(hi - lo);
    const u32x4 s = v[WIN / 2];
    u32x4 o;
    o.x = pk2((acc[0] * inv - lo_bf(s.x)) * p0[0] * silu(lo_bf(gt.x)), (acc[1] * inv - hi_bf(s.x)) * p0[1] * silu(hi_bf(gt.x)));
    o.y = pk2((acc[2] * inv - lo_bf(s.y)) * p0[2] * silu(lo_bf(gt.y)), (acc[3] * inv - hi_bf(s.y)) * p0[3] * silu(hi_bf(gt.y)));
    o.z = pk2((acc[4] * inv - lo_bf(s.z)) * p1[0] * silu(lo_bf(gt.z)), (acc[5] * inv - hi_bf(s.z)) * p1[1] * silu(hi_bf(gt.z)));
    o.w = pk2((acc[6] * inv - lo_bf(s.w)) * p1[2] * silu(lo_bf(gt.w)), (acc[7] * inv - hi_bf(s.w)) * p1[3] * silu(hi_bf(gt.w)));
    *(u32x4*)gp = o;
}
DI void phase_poolmix(const Params& p, int j, int row_lo, int nrows, int bid, int nb) {
    bf16_t* H = (bf16_t*)(p.ws + WS_H);
    const float* Z = p.in[18] + (size_t)j * D;
    const int lane = threadIdx.x & 63, wave = threadIdx.x >> 6;
    const int gw = bid * 8 + wave, nw = nb * 8;
    for (int it = row_lo * 4 + gw; it < nrows * 4; it += nw) {
        const int r = it >> 2, gq = it & 3;
        if (gq == 0) pool_item<2>(H, Z, r, gq, lane);
        else if (gq == 1) pool_item<4>(H, Z, r, gq, lane);
        else if (gq == 2) pool_item<8>(H, Z, r, gq, lane);
        else pool_item<16>(H, Z, r, gq, lane);
    }
}


#define XB_TMO      128
#define XB_XCNT(j)  (256  + 64 * (j))
#define XB_XSUB(j)  (1280 + 64 * (j))
#define XB_XGEN(j)  (2304 + 64 * (j))
#define XB_TOP      3328
#define XB_TOPGEN   3392
#define XCD_BAR_WORDS 3456
#define XB_SPIN_CAP (1u << 18)
DI unsigned xb_xcc_id() { return (unsigned)__builtin_amdgcn_s_getreg((3 << 11) | 20) & 0xFu; }
#define XB_SPIN(cond, bar) do { unsigned _sp = 0; while (cond) { __builtin_amdgcn_s_sleep(1); \
    if ((++_sp & 255u) == 0u) { if (xb_ld(&(bar)[XB_TMO])) break; if (_sp > XB_SPIN_CAP) { atomicAdd(&(bar)[XB_TMO], 1u); break; } } } } while (0)
struct XcdBarrier { unsigned* bar; unsigned x; volatile LAS unsigned* st; };
DI XcdBarrier xcd_barrier_post(unsigned* bar, volatile LAS unsigned* st) {
    XcdBarrier b; b.bar = bar; b.x = xb_xcc_id(); b.st = st;
    if (threadIdx.x == 0) (void)xb_add(&bar[XB_XCNT(b.x)], 1u);
    return b;
}
DI void xcd_barrier_complete(unsigned* bar, unsigned x, unsigned& nloc, unsigned& nx) {
    const unsigned G = gridDim.x * gridDim.y * gridDim.z;
    unsigned sum, cnt, mine, sp = 0u;
    for (;;) {
        sum = 0u; cnt = 0u; mine = 0u;
#pragma unroll
        for (unsigned j = 0; j < 16; ++j) { const unsigned c = xb_ld(&bar[XB_XCNT(j)]); sum += c; cnt += (c > 0u) ? 1u : 0u; mine = (j == x) ? c : mine; }
        if (sum == G) break;
        __builtin_amdgcn_s_sleep(1);
        if ((++sp & 255u) == 0u) { if (xb_ld(&bar[XB_TMO])) break; if (sp > XB_SPIN_CAP) { atomicAdd(&bar[XB_TMO], 1u); break; } }
    }
    nloc = mine > 0u ? mine : 1u; nx = cnt > 0u ? cnt : 1u;
}
DI void xcd_barrier(const XcdBarrier& b) {
    asm volatile("s_waitcnt vmcnt(0)" ::: "memory");
    __syncthreads();
    if (threadIdx.x == 0) {
        unsigned* bar = b.bar;
        __builtin_amdgcn_s_waitcnt(0);
        unsigned nloc = b.st[0], nx = b.st[1];
        if (nloc == 0u) { xcd_barrier_complete(bar, b.x, nloc, nx); b.st[0] = nloc; b.st[1] = nx; }
        const unsigned old = xb_add(&bar[XB_XSUB(b.x)], 1u);
        const unsigned gen = old / nloc;
        if (old + 1u == (gen + 1u) * nloc) {
            __builtin_amdgcn_fence(__ATOMIC_RELEASE, "agent");
            asm volatile("s_waitcnt vmcnt(0)" ::: "memory");
            const unsigned og = xb_add(&bar[XB_TOP], 1u);
            const unsigned tg = og / nx;
            if (og + 1u == (tg + 1u) * nx) xb_add(&bar[XB_TOPGEN], 1u);
            else XB_SPIN(xb_ld(&bar[XB_TOPGEN]) == tg, bar);
            __builtin_amdgcn_fence(__ATOMIC_ACQUIRE, "agent");
            xb_add(&bar[XB_XGEN(b.x)], 1u);
            asm volatile("s_waitcnt vmcnt(0)" ::: "memory");
        } else {
            XB_SPIN(xb_ld(&bar[XB_XGEN(b.x)]) == gen, bar);
            __builtin_amdgcn_fence(__ATOMIC_ACQUIRE, "agent");
            asm volatile("s_waitcnt vmcnt(0)" ::: "memory");
        }
    }
    __syncthreads();
}

DI void gemm_in_even(const Params& p, int layer, LAS unsigned char* lds) {
    pg8::Gemm g{(const bf16_t*)(p.ws + WS_U), (const bf16_t*)(p.ws + win_off(layer)), R, HE, D, D, 0, D, 0};
    pg8::StaticOrder S; S.init(g.M, g.N, (int)gridDim.x, (int)blockIdx.x);
    EpiStoreBf16 E{(bf16_t*)(p.ws + WS_H), HE};
    pg8::gemm_phase(lds, g, S, E);
}
DI void gemm_in_odd(const Params& p, int M, LAS unsigned char* lds) {
    pg8::Gemm g{(const bf16_t*)(p.ws + WS_U), (const bf16_t*)(p.ws + WS_WIN), M, HON, D, D, 0, D, 0};
    pg8::StaticOrder S; S.init(g.M, g.N, (int)gridDim.x, (int)blockIdx.x);
    EpiStoreBf16 E{(bf16_t*)(p.ws + WS_H), HO};
    pg8::gemm_phase(lds, g, S, E);
}
DI void gemm_out(const Params& p, int layer, int row_base, int M, int bid, int nb, LAS unsigned char* lds) {
    const bool even = (layer & 1) == 0;
    const int ldh = even ? HE : HO;
    pg8::Gemm g{(const bf16_t*)(p.ws + WS_H) + (size_t)row_base * ldh + (even ? 6144 : 2048), (const bf16_t*)(p.ws + wout_off(layer)), M, D, D, ldh, 0, D, 0};
    pg8::StaticOrder S; S.init(g.M, g.N, nb, bid);
    const int lp = layer > 0 ? layer - 1 : 0;
    EpiOut E{p.out, (float*)(p.ws + WS_CTXV), p.in[0], p.in[2], (const float*)(p.ws + WS_MOD) + (size_t)(layer * 3) * 6144 + 4096, (const float*)(p.ws + WS_STATS),
             p.in[6] + (size_t)lp * D, p.in[7] + (size_t)lp * D, layer > 0 ? 1 : 0, row_base};
    pg8::gemm_phase(lds, g, S, E);
}
DI void phase5(const Params& p, LAS unsigned char* lds3) {
    const int bid = (int)blockIdx.x, nb = (int)gridDim.x;
    if (bid < 16) { phase_mix_gla(p, 0, TL, R, bid, 16); mini_barrier((unsigned*)(p.ws + WS_BAR) + 3648, 16u); gemm_out(p, 0, TL, TC, bid, 16, lds3); }
    else phase_mix_gla(p, 0, 0, TL, bid - 16, nb - 16);
}
DI void phase7(const Params& p, LAS unsigned char* lds3) {
    const int bid = (int)blockIdx.x, nb = (int)gridDim.x;
    if (bid < 32) {
        phase_norm(p, 1, 0, TL, R, bid, 32); mini_barrier((unsigned*)(p.ws + WS_BAR) + 3712, 32u);
        pg8::Gemm g{(const bf16_t*)(p.ws + WS_U) + (size_t)TL * D, (const bf16_t*)(p.ws + WS_WIN), TC, HON, D, D, 0, D, 0};
        pg8::StaticOrder S; S.init(g.M, g.N, 32, bid);
        EpiStoreBf16 E{(bf16_t*)(p.ws + WS_H) + (size_t)TL * HO, HO};
        pg8::gemm_phase(lds3, g, S, E);
    } else phase_norm(p, 1, 0, 0, TL, bid - 32, nb - 32);
}
DI void phase9(const Params& p, LAS unsigned char* lds3) {
    const int bid = (int)blockIdx.x, nb = (int)gridDim.x;
    if (bid < 16) { phase_poolmix(p, 0, TL, R, bid, 16); mini_barrier((unsigned*)(p.ws + WS_BAR) + 3776, 16u); gemm_out(p, 1, TL, TC, bid, 16, lds3); }
    else phase_poolmix(p, 0, 0, TL, bid - 16, nb - 16);
}

DI Params load_params() {
#if defined(__HIP_DEVICE_COMPILE__)
    typedef const Params __attribute__((address_space(4))) CParams;
    CParams* kp = (CParams*)__builtin_amdgcn_kernarg_segment_ptr(); asm volatile("" : "+s"(kp)); return *kp;
#else
    return Params{};
#endif
}
__global__ void __launch_bounds__(512, 2) mega(Params p0) {
    extern __shared__ __attribute__((aligned(16))) unsigned char shm[];
    LAS unsigned char* lds3 = (LAS unsigned char*)shm;
    const int ph_lo = p0.ph_lo, ph_hi = p0.ph_hi;
    volatile LAS unsigned* xst = (volatile LAS unsigned*)(lds3 + LDS_MAIN);
    if (threadIdx.x < 4) xst[threadIdx.x] = 0u;
    __syncthreads();
    const XcdBarrier xb = xcd_barrier_post((unsigned*)(p0.ws + WS_BAR), xst);
#define PH(k, ...) if (ph_lo <= (k) && (k) < ph_hi) { if ((k) > ph_lo) { if (ph_hi == 0x7fffffff) cg::this_grid().sync(); else xcd_barrier(xb); } \
        const Params p = load_params(); __VA_ARGS__; if ((k) == DUP) { xcd_barrier(xb); __VA_ARGS__; } }
    PH(0, phase_mod(p, shm); phase_convert(p, 0, shm, 3, (int)blockIdx.x, (int)gridDim.x))
    PH(1, phase_norm(p, 0, 0, 0, R, (int)blockIdx.x, (int)gridDim.x))
    PH(2, gemm_in_even(p, 0, lds3))
    PH(3, phase_prep(p, 0, shm))
    PH(4, phase_scan(p, lds3, shm, 0, R, 1))
    PH(5, phase5(p, lds3))
    PH(6, gemm_out(p, 0, 0, TL, (int)blockIdx.x, (int)gridDim.x, lds3))
    PH(7, phase7(p, lds3))
    PH(8, gemm_in_odd(p, TL, lds3))
    PH(9, phase9(p, lds3))
    PH(11, gemm_out(p, 1, 0, TL, (int)blockIdx.x, (int)gridDim.x, lds3))
    PH(12, phase_norm(p, 1, 1, 0, R, (int)blockIdx.x, (int)gridDim.x))
    PH(13, gemm_in_even(p, 2, lds3))
    PH(14, phase_prep(p, 1, shm))
    PH(15, phase_scan(p, lds3, shm, 1, TL, 3))
    PH(16, phase_mix_gla(p, 1, 0, TL, (int)blockIdx.x, (int)gridDim.x))
    PH(17, gemm_out(p, 2, 0, TL, (int)blockIdx.x, (int)gridDim.x, lds3))
    PH(18, phase_norm(p, 1, 2, 0, TL, (int)blockIdx.x, (int)gridDim.x))
    PH(19, gemm_in_odd(p, TL, lds3))
    PH(20, phase_poolmix(p, 1, 0, TL, (int)blockIdx.x, (int)gridDim.x))
    PH(22, gemm_out(p, 3, 0, TL, (int)blockIdx.x, (int)gridDim.x, lds3))
    PH(23, phase_norm(p, 2, 3, 0, TL, (int)blockIdx.x, (int)gridDim.x))
#undef PH
}

extern "C" void kernel_launch(void* const* d_in, const int* in_sizes, int n_in, void* d_out, int out_size, void* d_ws, size_t ws_size, hipStream_t stream) {
    static int grid = 0;
    if (grid == 0) {
        if (n_in != 20 || ws_size < WS_END) { fprintf(stderr, "kernel_launch: unexpected n_in %d / ws_size %zu\n", n_in, ws_size); grid = -1; return; }
        int dev = 0, cus = 0, per_cu = 0;
        hipGetDevice(&dev);
        hipDeviceGetAttribute(&cus, hipDeviceAttributeMultiprocessorCount, dev);
        if (hipFuncSetAttribute((const void*)mega, hipFuncAttributeMaxDynamicSharedMemorySize, LDS_BYTES) != hipSuccess) { fprintf(stderr, "hipFuncSetAttribute failed\n"); grid = -1; return; }
        if (hipOccupancyMaxActiveBlocksPerMultiprocessor(&per_cu, (const void*)mega, 512, LDS_BYTES) != hipSuccess || per_cu < 1) { fprintf(stderr, "occupancy query: %d\n", per_cu); per_cu = 1; }
        (void)hipGetLastError();
        grid = cus * per_cu;
    }
    if (grid < 0) return;
    Params p{};
    for (int i = 0; i < 20; ++i) p.in[i] = (const float*)d_in[i];
    p.out = (float*)d_out; p.ws = (unsigned char*)d_ws;
    (void)hipMemsetAsync((char*)d_ws + WS_BAR, 0, 4096 * 4, stream);
#if MULTI
    for (int ph = 0; ph < NPHASE; ++ph) {
        p.ph_lo = ph; p.ph_hi = ph + 1;
        hipLaunchKernelGGL(mega, dim3(grid), dim3(512), LDS_BYTES, stream, p);
    }
#else
    p.ph_lo = 0; p.ph_hi = NPHASE;
    void* args[] = {&p};
    hipError_t e = hipLaunchCooperativeKernel((const void*)mega, dim3(grid), dim3(512), args, LDS_BYTES, stream);
    if (e != hipSuccess) fprintf(stderr, "cooperative launch failed: %s (grid %d)\n", hipGetErrorString(e), grid);
#endif
}
```
